# Optimizing an MI355X kernel written in HIP

```python
import math
import jax, jax.numpy as jnp
from jax import lax
import numpy as np

D_MODEL = 2048
BATCH = 4
SEQ = 4096
DEPTH = 2
DEC_BATCH = 16
DEC_SEQ = 64
PAST_LEN = 2048

CHUNK = 64
N_MIXERS = 2
N_A_LAYERS = (DEPTH + 1) // 2
N_B_LAYERS = DEPTH // 2
A_HEADS = 16
A_HEAD_DIM = D_MODEL // A_HEADS
BAND_CHUNKS = 8
BAND_ROWS = BAND_CHUNKS * CHUNK
REL_CLIP = 4 * CHUNK
MLA_HEADS = 16
MLA_Q_RANK = D_MODEL // 4
MLA_KV_RANK = D_MODEL // 4
MLA_NOPE_DIM = 128
MLA_ROPE_DIM = 64
MLA_V_DIM = 128
ROPE_THETA = 10000.0
Q_BLOCK = 128
D_FF = 4 * D_MODEL
NORM_EPS = 1e-6
NEG_INF = -1e30

kernel_name = "hybrid_streaming_band_mla_step"


def rmsnorm(x, g):
    xf = x.astype(jnp.float32)
    y = xf * lax.rsqrt(jnp.mean(xf * xf, axis=-1, keepdims=True) + NORM_EPS)
    return (y * g.astype(jnp.float32)).astype(x.dtype)


def rope(x, pos):
    half = x.shape[-1] // 2
    inv = 1.0 / (ROPE_THETA ** (jnp.arange(half, dtype=jnp.float32) / half))
    ang = pos.astype(jnp.float32)[:, None] * inv[None, :]
    shp = (pos.shape[0],) + (1,) * (x.ndim - 3) + (half,)
    cos = jnp.cos(ang).reshape(shp)
    sin = jnp.sin(ang).reshape(shp)
    xf = x.astype(jnp.float32)
    x1, x2 = xf[..., :half], xf[..., half:]
    return jnp.concatenate([x1 * cos - x2 * sin, x2 * cos + x1 * sin], axis=-1).astype(x.dtype)


def masked_softmax(scores, mask):
    return jax.nn.softmax(jnp.where(mask, scores, NEG_INF), axis=-1)


def a_project(h, w_qkv):
    b, s, _ = h.shape
    qkv = (h @ w_qkv).reshape(b, s, 3, A_HEADS, A_HEAD_DIM)
    return qkv[:, :, 0], qkv[:, :, 1], qkv[:, :, 2]


def band_attend(q, k, v, q_pos, k_pos, rel_bias):
    scores = jnp.einsum('bqhd,bkhd->bhqk', q, k).astype(jnp.float32) * (A_HEAD_DIM ** -0.5)
    rel = jnp.clip(q_pos[:, None] - k_pos[None, :], -REL_CLIP, REL_CLIP) + REL_CLIP
    scores = scores + rel_bias[:, rel].astype(jnp.float32)[None]
    qc = q_pos[:, None] // CHUNK
    kc = k_pos[None, :] // CHUNK
    mask = (k_pos[None, :] >= 0) & (kc <= qc) & (kc >= qc - BAND_CHUNKS)
    p = masked_softmax(scores, mask[None, None])
    return jnp.einsum('bhqk,bkhd->bqhd', p.astype(v.dtype), v)


def mixer_a_prompt(h, w_qkv, w_o, rel_bias):
    b, s, _ = h.shape
    q, k, v = a_project(h, w_qkv)
    pad = ((0, 0), (BAND_ROWS, 0), (0, 0), (0, 0))
    kpad, vpad = jnp.pad(k, pad), jnp.pad(v, pad)
    band = BAND_ROWS + CHUNK

    def one_chunk(c):
        start = c * CHUNK
        q_c = lax.dynamic_slice_in_dim(q, start, CHUNK, axis=1)
        k_b = lax.dynamic_slice_in_dim(kpad, start, band, axis=1)
        v_b = lax.dynamic_slice_in_dim(vpad, start, band, axis=1)
        q_pos = start + jnp.arange(CHUNK)
        k_pos = start - BAND_ROWS + jnp.arange(band)
        return band_attend(q_c, k_b, v_b, q_pos, k_pos, rel_bias)

    o = lax.map(one_chunk, jnp.arange(s // CHUNK))
    o = jnp.moveaxis(o, 0, 1).reshape(b, s, A_HEADS * A_HEAD_DIM)
    keep = min(BAND_ROWS, s)
    return o @ w_o, k[:, s - keep:], v[:, s - keep:]


def mixer_a_sample(h, cache_k, cache_v, w_qkv, w_o, rel_bias):
    b, s, _ = h.shape
    q, k, v = a_project(h, w_qkv)
    n_cache = cache_k.shape[1]
    kk = jnp.concatenate([cache_k.astype(k.dtype), k], axis=1)
    vv = jnp.concatenate([cache_v.astype(v.dtype), v], axis=1)
    q_pos = PAST_LEN + jnp.arange(s)
    k_pos = jnp.concatenate([PAST_LEN - n_cache + jnp.arange(n_cache), q_pos])
    o = band_attend(q, kk, vv, q_pos, k_pos, rel_bias).reshape(b, s, A_HEADS * A_HEAD_DIM)
    return o @ w_o, k, v


def mla_project(h, pos, w_dq, q_norm, w_uq, w_dkv, kv_norm, w_uk):
    cq = rmsnorm(h @ w_dq, q_norm)
    q = jnp.einsum('bsr,rhe->bshe', cq, w_uq)
    q_nope, q_rope = q[..., :MLA_NOPE_DIM], rope(q[..., MLA_NOPE_DIM:], pos)
    q_lat = jnp.einsum('bshn,chn->bshc', q_nope, w_uk)
    dkv = h @ w_dkv
    ckv = rmsnorm(dkv[..., :MLA_KV_RANK], kv_norm)
    kr = rope(dkv[..., MLA_KV_RANK:], pos)
    return q_lat, q_rope, ckv, kr


def mla_attend(q_lat, q_rope, ckv, kr, q_pos, k_pos, w_uv):
    s = jnp.einsum('bqhc,bkc->bhqk', q_lat, ckv) + jnp.einsum('bqhr,bkr->bhqk', q_rope, kr)
    s = s.astype(jnp.float32) * ((MLA_NOPE_DIM + MLA_ROPE_DIM) ** -0.5)
    mask = (k_pos[None, :] // CHUNK) <= (q_pos[:, None] // CHUNK)
    p = masked_softmax(s, mask[None, None])
    o_lat = jnp.einsum('bhqk,bkc->bqhc', p.astype(ckv.dtype), ckv)
    return jnp.einsum('bqhc,chv->bqhv', o_lat, w_uv)


def mixer_b_prompt(h, w_dq, q_norm, w_uq, w_dkv, kv_norm, w_uk, w_uv, w_o):
    b, s, _ = h.shape
    pos = jnp.arange(s)
    q_lat, q_rope, ckv, kr = mla_project(h, pos, w_dq, q_norm, w_uq, w_dkv, kv_norm, w_uk)

    def one_block(n):
        start = n * Q_BLOCK
        ql = lax.dynamic_slice_in_dim(q_lat, start, Q_BLOCK, axis=1)
        qr = lax.dynamic_slice_in_dim(q_rope, start, Q_BLOCK, axis=1)
        return mla_attend(ql, qr, ckv, kr, start + jnp.arange(Q_BLOCK), pos, w_uv)

    o = lax.map(one_block, jnp.arange(s // Q_BLOCK))
    o = jnp.moveaxis(o, 0, 1).reshape(b, s, MLA_HEADS * MLA_V_DIM)
    return o @ w_o, ckv, kr


def mixer_b_sample(h, cache_ckv, cache_kr, w_dq, q_norm, w_uq, w_dkv, kv_norm, w_uk, w_uv, w_o):
    b, s, _ = h.shape
    q_pos = PAST_LEN + jnp.arange(s)
    q_lat, q_rope, ckv, kr = mla_project(h, q_pos, w_dq, q_norm, w_uq, w_dkv, kv_norm, w_uk)
    n_cache = cache_ckv.shape[1]
    ckv_all = jnp.concatenate([cache_ckv.astype(ckv.dtype), ckv], axis=1)
    kr_all = jnp.concatenate([cache_kr.astype(kr.dtype), kr], axis=1)
    k_pos = jnp.concatenate([PAST_LEN - n_cache + jnp.arange(n_cache), q_pos])
    o = mla_attend(q_lat, q_rope, ckv_all, kr_all, q_pos, k_pos, w_uv).reshape(b, s, MLA_HEADS * MLA_V_DIM)
    return o @ w_o, ckv, kr


def sq_relu_mlp(h, w1, w2):
    return jnp.square(jax.nn.relu(h @ w1)) @ w2


def setup_inputs(seed: int = 0) -> dict:
    key = jax.random.key(seed)
    ks = jax.random.split(key, 24)
    f32 = jnp.float32

    def nrm(k, shape, fan_in):
        return jax.random.normal(k, shape, f32) * (fan_in ** -0.5)

    def gain(k, shape):
        return 1.0 + 0.01 * jax.random.normal(k, shape, f32)

    a_win = min(BAND_ROWS, PAST_LEN)
    hd_a = A_HEADS * A_HEAD_DIM
    return {
        "x_prompt": jax.random.normal(ks[0], (BATCH, SEQ, D_MODEL), f32),
        "x_sample": jax.random.normal(ks[1], (DEC_BATCH, DEC_SEQ, D_MODEL), f32),
        "cache_a_k": jax.random.normal(ks[2], (N_A_LAYERS, DEC_BATCH, a_win, A_HEADS, A_HEAD_DIM), f32),
        "cache_a_v": jax.random.normal(ks[3], (N_A_LAYERS, DEC_BATCH, a_win, A_HEADS, A_HEAD_DIM), f32),
        "cache_mla_ckv": jax.random.normal(ks[4], (N_B_LAYERS, DEC_BATCH, PAST_LEN, MLA_KV_RANK), f32),
        "cache_mla_kr": jax.random.normal(ks[5], (N_B_LAYERS, DEC_BATCH, PAST_LEN, MLA_ROPE_DIM), f32),
        "ln_mix_pre": gain(ks[6], (DEPTH, D_MODEL)),
        "ln_mix_post": gain(ks[7], (DEPTH, D_MODEL)),
        "ln_ffn_pre": gain(ks[8], (DEPTH, D_MODEL)),
        "ln_ffn_post": gain(ks[9], (DEPTH, D_MODEL)),
        "a_w_qkv": nrm(ks[10], (N_A_LAYERS, D_MODEL, 3 * hd_a), D_MODEL),
        "a_w_o": nrm(ks[11], (N_A_LAYERS, hd_a, D_MODEL), hd_a),
        "a_rel_bias": 0.1 * jax.random.normal(ks[12], (N_A_LAYERS, A_HEADS, 2 * REL_CLIP + 1), f32),
        "mla_w_dq": nrm(ks[13], (N_B_LAYERS, D_MODEL, MLA_Q_RANK), D_MODEL),
        "mla_q_norm": gain(ks[14], (N_B_LAYERS, MLA_Q_RANK)),
        "mla_w_uq": nrm(ks[15], (N_B_LAYERS, MLA_Q_RANK, MLA_HEADS, MLA_NOPE_DIM + MLA_ROPE_DIM), MLA_Q_RANK),
        "mla_w_dkv": nrm(ks[16], (N_B_LAYERS, D_MODEL, MLA_KV_RANK + MLA_ROPE_DIM), D_MODEL),
        "mla_kv_norm": gain(ks[17], (N_B_LAYERS, MLA_KV_RANK)),
        "mla_w_uk": nrm(ks[18], (N_B_LAYERS, MLA_KV_RANK, MLA_HEADS, MLA_NOPE_DIM), MLA_KV_RANK),
        "mla_w_uv": nrm(ks[19], (N_B_LAYERS, MLA_KV_RANK, MLA_HEADS, MLA_V_DIM), MLA_KV_RANK),
        "mla_w_o": nrm(ks[20], (N_B_LAYERS, MLA_HEADS * MLA_V_DIM, D_MODEL), MLA_HEADS * MLA_V_DIM),
        "ffn_w1": nrm(ks[21], (DEPTH, D_MODEL, D_FF), D_MODEL),
        "ffn_w2": nrm(ks[22], (DEPTH, D_FF, D_MODEL), D_FF),
    }


def reference(x_prompt, x_sample, cache_a_k, cache_a_v, cache_mla_ckv, cache_mla_kr,
              ln_mix_pre, ln_mix_post, ln_ffn_pre, ln_ffn_post,
              a_w_qkv, a_w_o, a_rel_bias,
              mla_w_dq, mla_q_norm, mla_w_uq, mla_w_dkv, mla_kv_norm, mla_w_uk, mla_w_uv, mla_w_o,
              ffn_w1, ffn_w2):
    xp, xs = x_prompt, x_sample
    a_k_p, a_v_p, a_k_s, a_v_s = [], [], [], []
    b_c_p, b_r_p, b_c_s, b_r_s = [], [], [], []
    for i in range(DEPTH):
        j = i // N_MIXERS
        hp = rmsnorm(xp, ln_mix_pre[i])
        hs = rmsnorm(xs, ln_mix_pre[i])
        if i % N_MIXERS == 0:
            op, kp, vp = mixer_a_prompt(hp, a_w_qkv[j], a_w_o[j], a_rel_bias[j])
            os_, ks_, vs_ = mixer_a_sample(hs, cache_a_k[j], cache_a_v[j], a_w_qkv[j], a_w_o[j], a_rel_bias[j])
            a_k_p.append(kp); a_v_p.append(vp); a_k_s.append(ks_); a_v_s.append(vs_)
        else:
            op, cp, rp = mixer_b_prompt(hp, mla_w_dq[j], mla_q_norm[j], mla_w_uq[j], mla_w_dkv[j],
                                        mla_kv_norm[j], mla_w_uk[j], mla_w_uv[j], mla_w_o[j])
            os_, cs_, rs_ = mixer_b_sample(hs, cache_mla_ckv[j], cache_mla_kr[j], mla_w_dq[j], mla_q_norm[j],
                                           mla_w_uq[j], mla_w_dkv[j], mla_kv_norm[j], mla_w_uk[j],
                                           mla_w_uv[j], mla_w_o[j])
            b_c_p.append(cp); b_r_p.append(rp); b_c_s.append(cs_); b_r_s.append(rs_)
        xp = xp + rmsnorm(op, ln_mix_post[i])
        xs = xs + rmsnorm(os_, ln_mix_post[i])
        xp = xp + rmsnorm(sq_relu_mlp(rmsnorm(xp, ln_ffn_pre[i]), ffn_w1[i], ffn_w2[i]), ln_ffn_post[i])
        xs = xs + rmsnorm(sq_relu_mlp(rmsnorm(xs, ln_ffn_pre[i]), ffn_w1[i], ffn_w2[i]), ln_ffn_post[i])
    y_prompt, y_sample = xp, xs
    new_a_k_prompt = jnp.stack(a_k_p, axis=0)
    new_a_v_prompt = jnp.stack(a_v_p, axis=0)
    new_a_k_sample = jnp.stack(a_k_s, axis=0)
    new_a_v_sample = jnp.stack(a_v_s, axis=0)
    new_mla_ckv_prompt = jnp.stack(b_c_p, axis=0)
    new_mla_kr_prompt = jnp.stack(b_r_p, axis=0)
    new_mla_ckv_sample = jnp.stack(b_c_s, axis=0)
    new_mla_kr_sample = jnp.stack(b_r_s, axis=0)
    return (y_prompt, y_sample, new_a_k_prompt, new_a_v_prompt, new_a_k_sample, new_a_v_sample,
            new_mla_ckv_prompt, new_mla_kr_prompt, new_mla_ckv_sample, new_mla_kr_sample)
```

```cpp
#include <hip/hip_runtime.h>
#include <hip/hip_cooperative_groups.h>
#include <cstdio>
#include <cstdint>
namespace cg = cooperative_groups;
namespace pg8 {
#define PG8_LAS __attribute__((address_space(3)))
typedef unsigned short bf16_t;
typedef short bf16x8 __attribute__((ext_vector_type(8)));
typedef float f32x4 __attribute__((ext_vector_type(4)));
typedef unsigned u32x4 __attribute__((ext_vector_type(4)));
constexpr int BM = 256, BK = 64, HALF = 128, HTB = HALF * BK * 2  , STAGE_BYTES = 8 * HTB, NXCD = 8, WGM = 8;

__host__ __device__ __forceinline__ int lds_byte(int r, int c) { const int st = (r >> 4) * 2 + (c >> 5), rr = r & 15, cc = c & 31, ob = rr * 64 + cc * 2; return st * 1024 + (ob ^ (((ob >> 9) & 1) << 5)); }
__host__ __device__ __forceinline__ void stage_rc(int b, int& R, int& C) { const int st = b / 1024, sb = b % 1024, swz = sb ^ (((sb >> 9) & 1) << 5); R = (st >> 1) * 16 + swz / 64; C = (st & 1) * 32 + (swz % 64) / 2; }
__host__ __device__ __forceinline__ int perm32(int rho) { const int n = rho >> 4, i = rho & 15; return 8 * (i >> 2) + 4 * n + (i & 3); }

struct Unit { int pm, pn, kb, nk, part; };
struct Gemm { const bf16_t* A; const bf16_t* Bt; int M, N, K; };

struct StaticOrder {
    int nM, nN, nwg, G, c, KT, ns;
    __host__ __device__ __forceinline__ void init(int M, int N, int K, int G_, int c_, int ns_) { nM = M / BM; nN = N / BM; nwg = nM * nN; G = G_; c = c_; KT = K / BK; ns = ns_; }
    __host__ __device__ __forceinline__ bool next(int i, Unit& uo) const {
        if (ns == 8) {
            const int L = i * G + c; Unit u;
            if (L < 512) {
                int wgid = L; { const int q = 512 / NXCD, xcd = wgid % NXCD, off = wgid / NXCD; wgid = xcd * q + off; }
                const int nig = WGM * nN; const int gid = wgid / nig, fm = gid * WGM;
                u.pm = fm + ((wgid % nig) % WGM); u.pn = (wgid % nig) / WGM; u.kb = 0; u.nk = KT; u.part = 2;
            } else {
                const int q = L - 512, t = q % 32, kp = q / 32;
                u.pm = 64 + t / 8; u.pn = t % 8; u.nk = KT / 8; u.kb = kp * u.nk; u.part = 16 + kp;
            }
            uo = u; return L < 768;
        }
        const int np = nwg * ns;
        const int L = i * G + c; const bool ok = L < np;
        int wgid = L; { const int q = np / NXCD, r = np % NXCD, xcd = wgid % NXCD, off = wgid / NXCD; wgid = (xcd < r ? xcd * (q + 1) : r * (q + 1) + (xcd - r) * q) + off; }
        const int half = wgid >= nwg ? 1 : 0; wgid -= half * nwg;
        const int nig = WGM * nN, gid = wgid / nig, fm = gid * WGM, gsz = (nM - fm) < WGM ? (nM - fm) : WGM;
        Unit u; u.pm = fm + ((wgid % nig) % gsz); u.pn = (wgid % nig) / gsz; u.nk = KT / ns; u.kb = half * u.nk; u.part = ns == 2 ? half : 2;
        uo = u; return ok;
    }
    __device__ __forceinline__ void a_ready(const Unit&) const {}
    __device__ __forceinline__ void done(const Unit&) const {}
};
__device__ __forceinline__ unsigned cvt_pk_bf16(float lo, float hi) { unsigned r; asm volatile("v_cvt_pk_bf16_f32 %0, %1, %2" : "=v"(r) : "v"(lo), "v"(hi)); return r; }
template <class Epi, class Sched, bool ALIGN_EPI = false, bool SP2 = false>
__device__ __forceinline__ void gemm_phase(PG8_LAS unsigned char* lds, const Gemm g, const Sched& S, const Epi& E) {
    int tid = threadIdx.x; asm volatile("" : "+v"(tid)); const int wid = __builtin_amdgcn_readfirstlane(tid >> 6), lane = tid & 63, wr = wid >> 2, wc = wid & 3, fr = lane & 15, fq = lane >> 4;
    const int K = g.K;
    unsigned voffA[2], voffB[2];
#pragma unroll
    for (int i = 0; i < 2; ++i) { int R, C; stage_rc(tid * 16 + i * 8192, R, C); const int Rb = Epi::PERM ? ((R & ~31) + perm32(R & 31)) : R;
        voffA[i] = (unsigned)(R * K + C) * 2u; voffB[i] = (unsigned)(Rb * K + C) * 2u; }
    const size_t kstep = (size_t)(BK * 2);
    const size_t hstep = (size_t)HALF * K * 2;
    const size_t tstep = 2 * hstep;
    const unsigned ldsw = (unsigned)wid * 1024u;
    const int aoff = lds_byte(wr * 64 + fr, fq * 8), boff = lds_byte(wc * 32 + fr, fq * 8);
#define PG8_SA(b, h) (((b) * 2 + (h)) * HTB)
#define PG8_SB(b, h) ((4 + (b) * 2 + (h)) * HTB)
#define PG8_STAGE(bufoff, gbase, voff) do { _Pragma("unroll") for (int _i = 0; _i < 2; ++_i) \
        __builtin_amdgcn_global_load_lds((const unsigned*)((const char*)(gbase) + (voff)[_i]), (PG8_LAS unsigned*)(lds + (bufoff) + ldsw + _i * 8192), 16, 0, 0); } while (0)
#define PG8_LDA(dst, b, h) do { _Pragma("unroll") for (int m = 0; m < 4; ++m) _Pragma("unroll") for (int k = 0; k < 2; ++k) dst[m][k] = *(const PG8_LAS bf16x8*)(lds + PG8_SA(b, h) + aoff + m * 2048 + k * 1024); } while (0)
#define PG8_LDB(dst, b, h) do { _Pragma("unroll") for (int n = 0; n < 2; ++n) _Pragma("unroll") for (int k = 0; k < 2; ++k) dst[n][k] = *(const PG8_LAS bf16x8*)(lds + PG8_SB(b, h) + boff + n * 2048 + k * 1024); } while (0)
#define PG8_MMA(ai, bj, At, Bt) do { __builtin_amdgcn_s_setprio(1); _Pragma("unroll") for (int m = 0; m < 4; ++m) _Pragma("unroll") for (int n = 0; n < 2; ++n) _Pragma("unroll") for (int k = 0; k < 2; ++k) \
        acc[ai][bj][m][n] = __builtin_amdgcn_mfma_f32_16x16x32_bf16(Bt[n][k], At[m][k], acc[ai][bj][m][n], 0, 0, 0); __builtin_amdgcn_s_setprio(0); } while (0)
#define PG8_WAIT_V(n) asm volatile("s_waitcnt vmcnt(" #n ")" ::: "memory")
#define PG8_WAIT_L(n) asm volatile("s_waitcnt lgkmcnt(" #n ")" ::: "memory")
#define PG8_BAR __builtin_amdgcn_s_barrier()
#define PG8_SCHED __builtin_amdgcn_sched_barrier(0)
    Unit cur, nxt; int ui = 0;
    if (!S.next(0, cur)) return;
    f32x4 acc[2][2][4][2];
#pragma unroll
    for (int a = 0; a < 2; ++a)
#pragma unroll
        for (int b = 0; b < 2; ++b)
#pragma unroll
            for (int m = 0; m < 4; ++m)
#pragma unroll
                for (int n = 0; n < 2; ++n) acc[a][b][m][n] = (f32x4){0.f, 0.f, 0.f, 0.f};
    bf16x8 At[4][2], B0[2][2], B1[2][2];
    const char* cA = (const char*)g.A + (size_t)cur.pm * tstep + (size_t)cur.kb * kstep; const char* cB = (const char*)g.Bt + (size_t)cur.pn * tstep + (size_t)cur.kb * kstep;
    S.a_ready(cur);
    if constexpr (SP2) {
        PG8_STAGE(PG8_SB(0, 0), cB, voffB); PG8_STAGE(PG8_SB(0, 1), cB + hstep, voffB); PG8_STAGE(PG8_SA(0, 0), cA, voffA); PG8_STAGE(PG8_SA(0, 1), cA + hstep, voffA);
        if (wr == 1) PG8_BAR;
        PG8_WAIT_V(2); PG8_BAR;
        PG8_STAGE(PG8_SB(1, 0), cB + kstep, voffB); PG8_STAGE(PG8_SA(1, 0), cA + kstep, voffA); PG8_STAGE(PG8_SB(1, 1), cB + hstep + kstep, voffB);
        PG8_WAIT_V(6); PG8_BAR;
    } else {
        PG8_STAGE(PG8_SB(0, 0), cB, voffB); PG8_STAGE(PG8_SA(0, 0), cA, voffA); PG8_STAGE(PG8_SB(0, 1), cB + hstep, voffB); PG8_STAGE(PG8_SA(0, 1), cA + hstep, voffA);
        if (wr == 1) PG8_BAR;
        PG8_WAIT_V(4); PG8_BAR;
        PG8_STAGE(PG8_SB(1, 0), cB + kstep, voffB); PG8_STAGE(PG8_SA(1, 0), cA + kstep, voffA); PG8_STAGE(PG8_SB(1, 1), cB + hstep + kstep, voffB);
        PG8_WAIT_V(6); PG8_BAR;
    }
    for (;;) {
        const bool has_next = S.next(ui + 1, nxt);
        const char* nA = has_next ? (const char*)g.A + (size_t)nxt.pm * tstep + (size_t)nxt.kb * kstep : cA; const char* nB = has_next ? (const char*)g.Bt + (size_t)nxt.pn * tstep + (size_t)nxt.kb * kstep : cB;
        const int nt = cur.nk;
        for (int t = 0; t < nt; t += 2) {
            const bool last = (t == nt - 2);
            const char* a1 = cA + (size_t)(t + 1) * kstep;
            const char* a2 = last ? nA : cA + (size_t)(t + 2) * kstep; const char* b2 = last ? nB : cB + (size_t)(t + 2) * kstep;
            const char* a3 = a2 + kstep; const char* b3 = b2 + kstep;
            if (last && has_next) S.a_ready(nxt);
            if constexpr (SP2) {
            PG8_LDB(B0, 0, 0); PG8_LDB(B1, 0, 1); PG8_SCHED; PG8_LDA(At, 0, 0); PG8_STAGE(PG8_SA(1, 1), a1 + hstep, voffA);
            PG8_WAIT_V(8); PG8_WAIT_L(0); PG8_BAR; PG8_MMA(0, 0, At, B0); PG8_MMA(0, 1, At, B1); PG8_BAR; PG8_SCHED;
            PG8_LDA(At, 0, 1); PG8_STAGE(PG8_SB(0, 0), b2, voffB); PG8_STAGE(PG8_SB(0, 1), b2 + hstep, voffB); PG8_STAGE(PG8_SA(0, 0), a2, voffA);
            PG8_WAIT_V(8); PG8_WAIT_L(0); PG8_BAR; PG8_MMA(1, 0, At, B0); PG8_MMA(1, 1, At, B1); PG8_BAR; PG8_SCHED;
            PG8_LDB(B0, 1, 0); PG8_LDB(B1, 1, 1); PG8_SCHED; PG8_LDA(At, 1, 0); PG8_STAGE(PG8_SA(0, 1), a2 + hstep, voffA);
            PG8_WAIT_V(8); PG8_WAIT_L(0); PG8_BAR; PG8_MMA(0, 0, At, B0); PG8_MMA(0, 1, At, B1); PG8_BAR; PG8_SCHED;
            PG8_LDA(At, 1, 1); PG8_STAGE(PG8_SB(1, 0), b3, voffB); PG8_STAGE(PG8_SB(1, 1), b3 + hstep, voffB); PG8_STAGE(PG8_SA(1, 0), a3, voffA);
            PG8_WAIT_V(8); PG8_WAIT_L(0); PG8_BAR; PG8_MMA(1, 0, At, B0); PG8_MMA(1, 1, At, B1); PG8_BAR; PG8_SCHED;
            } else {
            PG8_LDB(B0, 0, 0); PG8_SCHED; PG8_LDA(At, 0, 0); PG8_STAGE(PG8_SA(1, 1), a1 + hstep, voffA);
            PG8_WAIT_L(8); PG8_BAR; PG8_WAIT_L(0); PG8_MMA(0, 0, At, B0); PG8_BAR; PG8_SCHED;
            PG8_LDB(B1, 0, 1); PG8_STAGE(PG8_SB(0, 0), b2, voffB);
            PG8_BAR; PG8_WAIT_L(0); PG8_MMA(0, 1, At, B1); PG8_BAR;
            PG8_LDA(At, 0, 1); PG8_STAGE(PG8_SA(0, 0), a2, voffA);
            PG8_BAR; PG8_WAIT_L(0); PG8_MMA(1, 0, At, B0); PG8_BAR; PG8_SCHED;
            PG8_STAGE(PG8_SB(0, 1), b2 + hstep, voffB);
            PG8_WAIT_V(6); PG8_BAR; PG8_MMA(1, 1, At, B1); PG8_BAR;
            PG8_LDB(B0, 1, 0); PG8_SCHED; PG8_LDA(At, 1, 0); PG8_STAGE(PG8_SA(0, 1), a2 + hstep, voffA);
            PG8_WAIT_L(8); PG8_BAR; PG8_WAIT_L(0); PG8_MMA(0, 0, At, B0); PG8_BAR; PG8_SCHED;
            PG8_LDB(B1, 1, 1); PG8_STAGE(PG8_SB(1, 0), b3, voffB);
            PG8_BAR; PG8_WAIT_L(0); PG8_MMA(0, 1, At, B1); PG8_BAR;
            PG8_LDA(At, 1, 1); PG8_STAGE(PG8_SA(1, 0), a3, voffA);
            PG8_BAR; PG8_WAIT_L(0); PG8_MMA(1, 0, At, B0); PG8_BAR; PG8_SCHED;
            PG8_STAGE(PG8_SB(1, 1), b3 + hstep, voffB);
            PG8_WAIT_V(6); PG8_BAR; PG8_MMA(1, 1, At, B1); PG8_BAR;
            }
        }
        if constexpr (ALIGN_EPI) { if (wr == 0) PG8_BAR; }
        if constexpr (!Epi::AFTER_DRAIN) { E(acc, cur, wr, wc, fr, fq); S.done(cur); }
        if (!has_next) break;
#pragma unroll
        for (int a = 0; a < 2; ++a)
#pragma unroll
            for (int b = 0; b < 2; ++b)
#pragma unroll
                for (int m = 0; m < 4; ++m)
#pragma unroll
                    for (int n = 0; n < 2; ++n) acc[a][b][m][n] = (f32x4){0.f, 0.f, 0.f, 0.f};
        cur = nxt; cA = nA; cB = nB; ++ui;
        if constexpr (ALIGN_EPI) { if (wr == 1) PG8_BAR; }
    }
    PG8_WAIT_V(0);
    if constexpr (!ALIGN_EPI) { if (wr == 0) PG8_BAR; }
    PG8_BAR;
    if constexpr (Epi::AFTER_DRAIN) { E.fused(acc, cur, wr, wc, fr, fq, lds, wid, lane); S.done(cur); }
#undef PG8_SA
#undef PG8_SB
#undef PG8_STAGE
#undef PG8_LDA
#undef PG8_LDB
#undef PG8_MMA
#undef PG8_WAIT_V
#undef PG8_WAIT_L
#undef PG8_BAR
#undef PG8_SCHED
}
}
#define LAS __attribute__((address_space(3)))
#define DI __device__ __forceinline__
typedef unsigned short bf16;
typedef float f32x4 __attribute__((ext_vector_type(4)));
typedef float f32x8 __attribute__((ext_vector_type(8)));
typedef float f32x16 __attribute__((ext_vector_type(16)));
typedef short bf16x8 __attribute__((ext_vector_type(8)));
typedef short s16x4 __attribute__((ext_vector_type(4)));
typedef unsigned u32x4 __attribute__((ext_vector_type(4)));
typedef unsigned u32x2 __attribute__((ext_vector_type(2)));

constexpr int DM = 2048, NPR = 16384, NSA = 1024, MT = NPR + NSA, SEQ = 4096, DEC = 64, PAST = 2048, DFF = 8192;
constexpr float EPS = 1e-6f;
constexpr float LOG2E = 1.4426950408889634f;

constexpr size_t O_Y = 0, O_AKP = 35651584, O_AVP = 39845888, O_AKS = 44040192, O_AVS = 46137344,
                 O_CKVP = 48234496, O_KRP = 56623104, O_CKVS = 57671680, O_KRS = 58195968, O_END = 58261504;
constexpr size_t MiB = 1u << 20;
constexpr size_t W_QKV = 0, W_AO = 24 * MiB, W_D = 32 * MiB, W_UQ = 37 * MiB, W_UKV = 40 * MiB, W_MO = 44 * MiB, W_F1 = 52 * MiB, W_F2 = 84 * MiB;
constexpr size_t A_H = 116 * MiB, A_T = 184 * MiB, A_R = 252 * MiB;
constexpr size_t A_Q0 = A_R, A_KP = A_R + 68 * MiB, A_VP = A_KP + 64 * MiB, A_KS = A_VP + 64 * MiB, A_VS = A_KS + 36 * MiB, A_O0 = A_VS + 36 * MiB;
constexpr size_t A_PF = 528 * MiB;
constexpr size_t A_HID = A_R;
constexpr size_t A_CKVP = A_R, A_CKVS = A_R + 16 * MiB, A_KRP = A_CKVS + 33 * MiB, A_KRS = A_KRP + 2 * MiB, A_QM = A_KRS + 5 * MiB, A_KNV = A_QM + 102 * MiB;
constexpr size_t A_DQ = A_KNV, A_CQ = A_KNV + 130 * MiB, A_O1 = A_H;
constexpr size_t A_BAR = A_KNV + 264 * MiB;
constexpr size_t WS_NEED = A_BAR + 65536;

DI unsigned cvtpk(float lo, float hi) { unsigned r; asm volatile("v_cvt_pk_bf16_f32 %0, %1, %2" : "=v"(r) : "v"(lo), "v"(hi)); return r; }
DI float bflo(unsigned w) { return __uint_as_float(w << 16); }
DI float bfhi(unsigned w) { return __uint_as_float(w & 0xffff0000u); }
DI float wave_sum(float v) {
  v += __int_as_float(__builtin_amdgcn_ds_swizzle(__float_as_int(v), (1 << 10) | 0x1f));
  v += __int_as_float(__builtin_amdgcn_ds_swizzle(__float_as_int(v), (2 << 10) | 0x1f));
  v += __int_as_float(__builtin_amdgcn_ds_swizzle(__float_as_int(v), (4 << 10) | 0x1f));
  v += __int_as_float(__builtin_amdgcn_ds_swizzle(__float_as_int(v), (8 << 10) | 0x1f));
  v += __int_as_float(__builtin_amdgcn_ds_swizzle(__float_as_int(v), (16 << 10) | 0x1f));
  auto rr = __builtin_amdgcn_permlane32_swap(__float_as_uint(v), __float_as_uint(v), false, false);
  return __uint_as_float(rr[0]) + __uint_as_float(rr[1]);
}
DI u32x4 pack8(f32x4 a, f32x4 b) { u32x4 w; w.x = cvtpk(a.x, a.y); w.y = cvtpk(a.z, a.w); w.z = cvtpk(b.x, b.y); w.w = cvtpk(b.z, b.w); return w; }


DI void sincos_cw(float x, float& sn, float& cs) {
  const float k = rintf(x * 0.63661977236758134f);
  float r = fmaf(-k, 1.5703125f, x); r = fmaf(-k, 4.837512969970703125e-4f, r); r = fmaf(-k, 7.54978995489188216e-8f, r);
  const float z = r * r;
  const float sp = fmaf(r * z, fmaf(z, fmaf(z, -1.9515295891e-4f, 8.3321608736e-3f), -1.6666654611e-1f), r);
  const float cp = fmaf(z * z, fmaf(z, fmaf(z, 2.443315711809948e-5f, -1.388731625493765e-3f), 4.166664568298827e-2f), fmaf(z, -0.5f, 1.0f));
  const int q = ((int)k) & 3;
  const float s1 = (q & 1) ? cp : sp, c1 = (q & 1) ? sp : cp;
  sn = (q & 2) ? -s1 : s1; cs = ((q + 1) & 2) ? -c1 : c1;
}
enum { EM_BF16 = 0, EM_QKV = 1, EM_RELU2 = 2, EM_F32 = 3, EM_QROPE = 4, EM_SPLIT = 5, EM_TAIL = 6 };
struct EpiMode {
  static constexpr bool PERM = true, AFTER_DRAIN = false;
  int mode; bf16* O; int ldc; float* F; float* outp;
  bf16* O2;
  unsigned char* ws;
  template <int MODE> DI void store8(int row, int col, f32x4 v0, f32x4 v1, int part) const {
    if (MODE == EM_TAIL) {
      if (part >= 16) *(u32x4*)(O2 + ((size_t)(part - 16) * 1024 + (row - NPR)) * 2048 + col) = pack8(v0, v1);
      else *(u32x4*)(O + (size_t)row * ldc + col) = pack8(v0, v1);
    } else if (MODE == EM_SPLIT) {
      bf16* d = (part & 1) ? O2 : O; *(u32x4*)(d + (size_t)row * ldc + col) = pack8(v0, v1);
      if (part & 2) *(u32x4*)(O2 + (size_t)row * ldc + col) = (u32x4){0u, 0u, 0u, 0u};
    } else if (MODE == EM_BF16) { *(u32x4*)(O + (size_t)row * ldc + col) = pack8(v0, v1); }
    else if (MODE == EM_RELU2) {
      f32x4 a = __builtin_elementwise_max(v0, (f32x4){0.f, 0.f, 0.f, 0.f}), b = __builtin_elementwise_max(v1, (f32x4){0.f, 0.f, 0.f, 0.f});
      *(u32x4*)(O + (size_t)row * ldc + col) = pack8(a * a, b * b); }
    else if (MODE == EM_F32) { if (col < 1088) *(u32x4*)((bf16*)F + (size_t)row * ldc + col) = pack8(v0, v1); }
    else if (MODE == EM_QKV) {
      const u32x4 w = pack8(v0, v1);
      if (col < 2048) { *(u32x4*)((bf16*)(ws + A_Q0) + (size_t)row * 2048 + col) = w; }
      else {
        const int isv = col >= 4096; const int c = col - (isv ? 4096 : 2048);
        if (row < NPR) {
          *(u32x4*)((bf16*)(ws + (isv ? A_VP : A_KP)) + (size_t)row * 2048 + c) = w;
          const int s = row & 4095, b = row >> 12;
          if (s >= 3584) { float* p = outp + (isv ? O_AVP : O_AKP) + ((size_t)(b * 512 + s - 3584)) * 2048 + c; *(f32x4*)p = v0; *(f32x4*)(p + 4) = v1; }
        } else {
          const int rs = row - NPR, b = rs >> 6, i = rs & 63;
          *(u32x4*)((bf16*)(ws + (isv ? A_VS : A_KS)) + ((size_t)(b * 576 + 512 + i)) * 2048 + c) = w;
          float* p = outp + (isv ? O_AVS : O_AKS) + (size_t)rs * 2048 + c; *(f32x4*)p = v0; *(f32x4*)(p + 4) = v1;
        }
      }
    } else if (MODE == EM_QROPE) {
      if (col >= 2048) {
        const int j = col - 2048, i0 = (j & 63) >> 1;
        const float pos = (float)(row < NPR ? (row & 4095) : PAST + ((row - NPR) & 63));
        float x[8] = {v0.x, v0.y, v0.z, v0.w, v1.x, v1.y, v1.z, v1.w};
#pragma unroll
        for (int p = 0; p < 4; ++p) {
          const float inv = exp2f(-(float)(i0 + p) * 0.41524101186092029f);
          float sn, cs; sincos_cw(pos * inv, sn, cs);
          const float a = x[2 * p], b = x[2 * p + 1];
          x[2 * p] = a * cs - b * sn; x[2 * p + 1] = b * cs + a * sn;
        }
        v0 = (f32x4){x[0], x[1], x[2], x[3]}; v1 = (f32x4){x[4], x[5], x[6], x[7]};
      }
      *(u32x4*)(O + (size_t)row * ldc + col) = pack8(v0, v1);
    }
  }
  template <int MODE> DI void run(const f32x4 (&acc)[2][2][4][2], const pg8::Unit& u, int wr, int wc, int fr, int fq) const {
#pragma unroll
    for (int ai = 0; ai < 2; ++ai)
#pragma unroll
      for (int m = 0; m < 4; ++m) {
        const int row = u.pm * 256 + ai * 128 + wr * 64 + m * 16 + fr;
#pragma unroll
        for (int bj = 0; bj < 2; ++bj) { store8<MODE>(row, u.pn * 256 + bj * 128 + wc * 32 + 8 * fq, acc[ai][bj][m][0], acc[ai][bj][m][1], u.part);
          if (MODE == EM_QROPE || MODE == EM_QKV) asm volatile("" ::: "memory"); }
      }
  }
  DI void operator()(const f32x4 (&acc)[2][2][4][2], const pg8::Unit& u, int wr, int wc, int fr, int fq) const {
    { int t_ = threadIdx.x; asm volatile("" : "+v"(t_)); fr = t_ & 15; fq = (t_ >> 4) & 3; }
    switch (mode) {
      case EM_BF16: run<EM_BF16>(acc, u, wr, wc, fr, fq); break;
      case EM_RELU2: run<EM_RELU2>(acc, u, wr, wc, fr, fq); break;
      case EM_F32: run<EM_F32>(acc, u, wr, wc, fr, fq); break;
      case EM_QKV: run<EM_QKV>(acc, u, wr, wc, fr, fq); break;
      case EM_SPLIT: run<EM_SPLIT>(acc, u, wr, wc, fr, fq); break;
      case EM_TAIL: run<EM_TAIL>(acc, u, wr, wc, fr, fq); break;
      default: run<EM_QROPE>(acc, u, wr, wc, fr, fq); break;
    }
  }
};
DI void run_gemm(LAS unsigned char* lds, const bf16* A, const bf16* Bt, int M, int N, int K, const EpiMode& E) {
  pg8::Gemm g{A, Bt, M, N, K}; pg8::StaticOrder S; S.init(M, N, K, (int)gridDim.x, (int)blockIdx.x, E.mode == EM_TAIL ? 8 : E.mode == EM_SPLIT ? 2 : 1);
  pg8::gemm_phase<EpiMode, pg8::StaticOrder, true, true>(lds, g, S, E);
}
DI void row_norm_to_bf16(const float* xrow, const float* g, bf16* hrow, bf16* xbrow, int lane) {
  const f32x4* xr = (const f32x4*)xrow + lane; const f32x4* gr = (const f32x4*)g + lane;
  f32x4 v[8]; float s = 0.f;
#pragma unroll
  for (int j = 0; j < 8; ++j) { v[j] = xr[64 * j]; s += (v[j].x * v[j].x + v[j].y * v[j].y) + (v[j].z * v[j].z + v[j].w * v[j].w); }
  const float rstd = rsqrtf(wave_sum(s) * (1.f / DM) + EPS);
  u32x2* o8 = (u32x2*)hrow + lane;
#pragma unroll
  for (int j = 0; j < 8; ++j) { const f32x4 gg = gr[64 * j]; u32x2 w; w.x = cvtpk(v[j].x * rstd * gg.x, v[j].y * rstd * gg.y); w.y = cvtpk(v[j].z * rstd * gg.z, v[j].w * rstd * gg.w); o8[64 * j] = w; }
  u32x2* x8 = (u32x2*)xbrow + lane;
#pragma unroll
  for (int j = 0; j < 8; ++j) { u32x2 w; w.x = cvtpk(v[j].x, v[j].y); w.y = cvtpk(v[j].z, v[j].w); x8[64 * j] = w; }
}
template <bool XINB, bool XOUTB> DI void row_resid_norm(const bf16* trow, const bf16* trow2, int npart, const void* xin, void* xout, const float* gpost, const float* gpre, bf16* hrow, int lane) {
  const u32x2* tr = (const u32x2*)trow + lane; const u32x2* tr2 = (const u32x2*)trow2 + lane; const f32x4* gr = (const f32x4*)gpost + lane;
  f32x4 t[8], x[8]; float s = 0.f;
#pragma unroll
  for (int j = 0; j < 8; ++j) {
    if (npart == 8) { f32x4 acc4 = {0.f, 0.f, 0.f, 0.f};
#pragma unroll
      for (int p = 0; p < 8; ++p) { const u32x2 w = (tr2 + (size_t)p * (1024 * 2048 / 4))[64 * j]; acc4 += (f32x4){bflo(w.x), bfhi(w.x), bflo(w.y), bfhi(w.y)}; }
      t[j] = acc4;
    } else { const u32x2 w = tr[64 * j]; u32x2 w2 = {0u, 0u}; if (npart == 1) w2 = tr2[64 * j]; t[j] = (f32x4){bflo(w.x) + bflo(w2.x), bfhi(w.x) + bfhi(w2.x), bflo(w.y) + bflo(w2.y), bfhi(w.y) + bfhi(w2.y)}; }
    s += (t[j].x * t[j].x + t[j].y * t[j].y) + (t[j].z * t[j].z + t[j].w * t[j].w); }
#pragma unroll
  for (int j = 0; j < 8; ++j) { if (XINB) { const u32x2 w = ((const u32x2*)xin + lane)[64 * j]; x[j] = (f32x4){bflo(w.x), bfhi(w.x), bflo(w.y), bfhi(w.y)}; } else x[j] = ((const f32x4*)xin + lane)[64 * j]; }
  const float rstd = rsqrtf(wave_sum(s) * (1.f / DM) + EPS);
  float s2 = 0.f;
#pragma unroll
  for (int j = 0; j < 8; ++j) { const f32x4 gg = gr[64 * j]; x[j] = x[j] + t[j] * rstd * gg; s2 += (x[j].x * x[j].x + x[j].y * x[j].y) + (x[j].z * x[j].z + x[j].w * x[j].w); }
  asm volatile("s_waitcnt vmcnt(0)" ::: "memory");
#pragma unroll
  for (int j = 0; j < 8; ++j) { if (XOUTB) { u32x2 w; w.x = cvtpk(x[j].x, x[j].y); w.y = cvtpk(x[j].z, x[j].w); ((u32x2*)xout + lane)[64 * j] = w; } else ((f32x4*)xout + lane)[64 * j] = x[j]; }
  if (gpre) {
    const float rstd2 = rsqrtf(wave_sum(s2) * (1.f / DM) + EPS);
    const f32x4* g2 = (const f32x4*)gpre + lane; u32x2* o8 = (u32x2*)hrow + lane;
#pragma unroll
    for (int j = 0; j < 8; ++j) { const f32x4 gg = g2[64 * j]; u32x2 w; w.x = cvtpk(x[j].x * rstd2 * gg.x, x[j].y * rstd2 * gg.y); w.y = cvtpk(x[j].z * rstd2 * gg.z, x[j].w * rstd2 * gg.w); o8[64 * j] = w; }
  }
}
DI bf16* xb_row(float* outp, int m) { return (bf16*)((char*)outp + (size_t)m * 8192 + 4096); }
DI void row_mla(const bf16* d, int row, const float* qn, const float* kvn, unsigned char* ws, float* outp, int lane) {
  f32x4 a[2], c[2]; float sa = 0.f, sc = 0.f;
#pragma unroll
  for (int j = 0; j < 2; ++j) { const u32x2 wa = *(const u32x2*)(d + 4 * lane + 256 * j), wc = *(const u32x2*)(d + 512 + 4 * lane + 256 * j);
    a[j] = (f32x4){bflo(wa.x), bfhi(wa.x), bflo(wa.y), bfhi(wa.y)}; c[j] = (f32x4){bflo(wc.x), bfhi(wc.x), bflo(wc.y), bfhi(wc.y)};
    sa += (a[j].x * a[j].x + a[j].y * a[j].y) + (a[j].z * a[j].z + a[j].w * a[j].w); sc += (c[j].x * c[j].x + c[j].y * c[j].y) + (c[j].z * c[j].z + c[j].w * c[j].w); }
  const float ra = rsqrtf(wave_sum(sa) * (1.f / 512.f) + EPS), rc = rsqrtf(wave_sum(sc) * (1.f / 512.f) + EPS);
  bf16* cq = (bf16*)(ws + A_CQ) + (size_t)row * 512;
  bf16* ckv; bf16* kr; float* fckv; float* fkr;
  if (row < NPR) { ckv = (bf16*)(ws + A_CKVP) + (size_t)row * 512; kr = (bf16*)(ws + A_KRP) + (size_t)row * 64; fckv = outp + O_CKVP + (size_t)row * 512; fkr = outp + O_KRP + (size_t)row * 64; }
  else { const int rs = row - NPR, b = rs >> 6, i = rs & 63; const size_t r2 = (size_t)b * 2112 + 2048 + i;
    ckv = (bf16*)(ws + A_CKVS) + r2 * 512; kr = (bf16*)(ws + A_KRS) + r2 * 64; fckv = outp + O_CKVS + (size_t)rs * 512; fkr = outp + O_KRS + (size_t)rs * 64; }
#pragma unroll
  for (int j = 0; j < 2; ++j) {
    const f32x4 g1 = *(const f32x4*)(qn + 4 * lane + 256 * j), g2 = *(const f32x4*)(kvn + 4 * lane + 256 * j);
    const f32x4 q = a[j] * ra * g1, k = c[j] * rc * g2;
    u32x2 w; w.x = cvtpk(q.x, q.y); w.y = cvtpk(q.z, q.w); *(u32x2*)(cq + 4 * lane + 256 * j) = w;
    w.x = cvtpk(k.x, k.y); w.y = cvtpk(k.z, k.w); *(u32x2*)(ckv + 4 * lane + 256 * j) = w;
    *(f32x4*)(fckv + 4 * lane + 256 * j) = k;
  }
  if (lane < 32) {
    const float x1 = __uint_as_float((unsigned)d[1024 + lane] << 16), x2 = __uint_as_float((unsigned)d[1056 + lane] << 16);
    const float pos = (float)(row < NPR ? (row & 4095) : PAST + ((row - NPR) & 63));
    const float inv = exp2f(-(float)lane * 0.41524101186092029f);
    float sn, cs; sincos_cw(pos * inv, sn, cs);
    const float o1 = x1 * cs - x2 * sn, o2 = x2 * cs + x1 * sn;
    fkr[lane] = o1; fkr[32 + lane] = o2;
    *(unsigned*)(kr + 2 * lane) = cvtpk(o1, o2);
  }
}

DI unsigned f2bf(float f) { unsigned u = __builtin_bit_cast(unsigned, f); return (u + 0x7fffu + ((u >> 16) & 1u)) >> 16; }
DI unsigned pk2(float lo, float hi) { return f2bf(lo) | (f2bf(hi) << 16); }
template <int RMAP> DI void transpose_item(const float* W, int K, int N, bf16* WT, int row_off, LAS float* scr, int item, int lane) {
  const int nblk = N / 64, kb = item / nblk, nb = item % nblk, k0 = 64 * kb, n0 = 64 * nb;
  const int lr = lane >> 4, lc = (lane & 15) * 4;
  f32x4 v[16];
#pragma unroll
  for (int i = 0; i < 16; ++i) v[i] = *(const f32x4*)(W + (size_t)(k0 + 4 * i + lr) * N + n0 + lc);
#pragma unroll
  for (int i = 0; i < 16; ++i) { LAS float* d = scr + (4 * i + lr) * 65 + lc; d[0] = v[i].x; d[1] = v[i].y; d[2] = v[i].z; d[3] = v[i].w; }
  asm volatile("s_waitcnt lgkmcnt(0)" ::: "memory");
  const int c = lane & 7;
#pragma unroll
  for (int j = 0; j < 8; ++j) { const int n = (lane >> 3) + 8 * j; const LAS float* s = scr + (8 * c) * 65 + n;
    u32x4 o; o.x = cvtpk(s[0 * 65], s[1 * 65]); o.y = cvtpk(s[2 * 65], s[3 * 65]); o.z = cvtpk(s[4 * 65], s[5 * 65]); o.w = cvtpk(s[6 * 65], s[7 * 65]);
    int orow = row_off + n0 + n;
    if (RMAP == 1) { const int nn = n0 + n, h = nn / 192, e = nn % 192; if (e < 128) orow = h * 128 + e; else { const int jj = e - 128; orow = 2048 + h * 64 + (jj < 32 ? 2 * jj : 2 * (jj - 32) + 1); } }
    *(u32x4*)(WT + (size_t)orow * K + k0 + 8 * c) = o; }
  asm volatile("s_waitcnt lgkmcnt(0)" ::: "memory");
}
namespace att {
constexpr int SHM_V = 16384, SHM_K = 64 * 272, SHM_KR = 64 * 144;
constexpr int OFF_V = 0, OFF_K = 2 * SHM_V, OFF_KR = OFF_K + 2 * SHM_K, OFF_WS = OFF_KR + 2 * SHM_KR, OFF_BIAS = OFF_WS + 8 * 64 * 4, LDS_END = OFF_BIAS + 640 * 4;
#define KSWZ(row, colB) ((row) * 272 + (colB))
#define KRSWZ(row, colB) ((row) * 144 + (colB))
#define SBAR() __builtin_amdgcn_sched_barrier(0)
DI int crow(int r, int hi) { return (r & 3) + 8 * (r >> 2) + 4 * hi; }
struct Unit {
  const bf16* Q; const bf16* Qr; int ldq;
  const bf16* K; const bf16* V; const bf16* KR; int ldk;
  bf16* O; int ldo;
  int nt, nact, thi0, tlo0, qrel0;
  const float* bias;
};
template <bool BAND> DI void partialSM(f32x16& p0, f32x16& p1, float& m_reg, float& mn, float& alpha, bool masked, const LAS float* tb, float C) {
  if (masked) {
#pragma unroll
    for (int r = 0; r < 16; ++r) { p0[r] = -1e30f; p1[r] = -1e30f; }
  } else if (BAND) {
#pragma unroll
    for (int r = 0; r < 16; ++r) { const int ko = (r & 3) + 8 * (r >> 2); p0[r] = fmaf(p0[r], C, tb[ko]); }
    SBAR();
#pragma unroll
    for (int r = 0; r < 16; ++r) { const int ko = (r & 3) + 8 * (r >> 2); p1[r] = fmaf(p1[r], C, tb[ko + 32]); }
  }
  const float CC = BAND ? 1.f : C;
  const float THRP = 11.5f / CC;
  float pmax = p0[0];
#pragma unroll
  for (int r = 1; r < 16; ++r) pmax = fmaxf(pmax, p0[r]);
#pragma unroll
  for (int r = 0; r < 16; ++r) pmax = fmaxf(pmax, p1[r]);
  { auto rr = __builtin_amdgcn_permlane32_swap(__float_as_uint(pmax), __float_as_uint(pmax), false, false);
    pmax = fmaxf(__uint_as_float(rr[0]), __uint_as_float(rr[1])); }
  if (__builtin_expect(__all(pmax - m_reg <= THRP), 1)) { mn = m_reg; alpha = 1.f; }
  else { mn = fmaxf(m_reg, pmax); alpha = __builtin_amdgcn_exp2f((m_reg - mn) * CC); m_reg = mn; }
  const float mnC = -mn * CC;
#pragma unroll
  for (int r = 0; r < 16; ++r) p0[r] = fmaf(p0[r], CC, mnC);
#pragma unroll
  for (int r = 0; r < 16; ++r) p1[r] = fmaf(p1[r], CC, mnC);
#pragma unroll
  for (int r = 0; r < 16; ++r) p0[r] = __builtin_amdgcn_exp2f(p0[r]);
}
DI void finishSM(f32x16& p0, f32x16& p1, float alpha, float& l_reg, bf16x8& pa0, bf16x8& pa1, bf16x8& pa2, bf16x8& pa3) {
#pragma unroll
  for (int r = 0; r < 16; ++r) p1[r] = __builtin_amdgcn_exp2f(p1[r]);
  float ps = 0;
#pragma unroll
  for (int r = 0; r < 16; ++r) ps += p0[r];
#pragma unroll
  for (int r = 0; r < 16; ++r) ps += p1[r];
  { auto rr = __builtin_amdgcn_permlane32_swap(__float_as_uint(ps), __float_as_uint(ps), false, false);
    ps = __uint_as_float(rr[0]) + __uint_as_float(rr[1]); }
  l_reg = l_reg * alpha + ps;
#define PK4(P, BASE, OUT) do { unsigned a0 = cvtpk(P[BASE + 0], P[BASE + 1]), a1 = cvtpk(P[BASE + 2], P[BASE + 3]);   \
    unsigned b0 = cvtpk(P[BASE + 4], P[BASE + 5]), b1 = cvtpk(P[BASE + 6], P[BASE + 7]);                              \
    auto r0 = __builtin_amdgcn_permlane32_swap(a0, b0, false, false); auto r1 = __builtin_amdgcn_permlane32_swap(a1, b1, false, false); \
    u32x4 w = {r0[0], r1[0], r0[1], r1[1]}; OUT = __builtin_bit_cast(bf16x8, w); } while (0)
  PK4(p0, 0, pa0); PK4(p0, 8, pa1); PK4(p1, 0, pa2); PK4(p1, 8, pa3);
#undef PK4
}
template <int NQ> DI void qkt(f32x16& p0, f32x16& p1, const LAS char* Ks, const LAS char* KRs, const bf16x8* qr, int r32, int hi) {
  p0 = f32x16{}; p1 = f32x16{};
#pragma unroll
  for (int d0 = 0; d0 < 8; ++d0) { const int cb = (d0 * 16 + hi * 8) * 2;
    const bf16x8 b0 = *(const LAS bf16x8*)(Ks + KSWZ(r32, cb));
    const bf16x8 b1 = *(const LAS bf16x8*)(Ks + KSWZ(32 + r32, cb));
    p0 = __builtin_amdgcn_mfma_f32_32x32x16_bf16(b0, qr[d0], p0, 0, 0, 0);
    p1 = __builtin_amdgcn_mfma_f32_32x32x16_bf16(b1, qr[d0], p1, 0, 0, 0); }
  if (NQ == 12) {
#pragma unroll
    for (int d0 = 0; d0 < 4; ++d0) { const int cb = (d0 * 16 + hi * 8) * 2;
      const bf16x8 b0 = *(const LAS bf16x8*)(KRs + KRSWZ(r32, cb));
      const bf16x8 b1 = *(const LAS bf16x8*)(KRs + KRSWZ(32 + r32, cb));
      p0 = __builtin_amdgcn_mfma_f32_32x32x16_bf16(b0, qr[8 + d0], p0, 0, 0, 0);
      p1 = __builtin_amdgcn_mfma_f32_32x32x16_bf16(b1, qr[8 + d0], p1, 0, 0, 0); }
  }
}
DI int v_st(int k, int c) { const int kk = (k & ~0xC) | ((k & 4) << 1) | ((k & 8) >> 1); return ((kk >> 3) * 4 + (c >> 5)) * 512 + ((kk & 7) * 32 + (c & 31)) * 2; }
DI int v_rd_base(int lane) { return ((lane & 3) << 3) | (((lane >> 2) & 3) << 6) | (((lane >> 4) & 1) << 5) | (((lane >> 5) & 1) << 8); }
constexpr int v_rd_off(int d0, int ks, int half) { return d0 * 512 + ks * 4096 + half * 2048; }
template <int OFF> DI s16x4 tr_read(int vb) { s16x4 r; asm volatile("ds_read_b64_tr_b16 %0, %1 offset:%2" : "=&v"(r) : "v"(vb), "i"(OFF) : "memory"); return r; }
template <int D0> DI void pv_one(f32x16& od, int vb, bf16x8 pa0, bf16x8 pa1, bf16x8 pa2, bf16x8 pa3) {
  const s16x4 l0 = tr_read<v_rd_off(D0, 0, 0)>(vb), h0 = tr_read<v_rd_off(D0, 0, 1)>(vb), l1 = tr_read<v_rd_off(D0, 1, 0)>(vb), h1 = tr_read<v_rd_off(D0, 1, 1)>(vb);
  const s16x4 l2 = tr_read<v_rd_off(D0, 2, 0)>(vb), h2 = tr_read<v_rd_off(D0, 2, 1)>(vb), l3 = tr_read<v_rd_off(D0, 3, 0)>(vb), h3 = tr_read<v_rd_off(D0, 3, 1)>(vb);
  asm volatile("s_waitcnt lgkmcnt(0)" ::: "memory"); SBAR();
#define PK(L, H) (bf16x8){L[0], L[1], L[2], L[3], H[0], H[1], H[2], H[3]}
  od = __builtin_amdgcn_mfma_f32_32x32x16_bf16(pa0, PK(l0, h0), od, 0, 0, 0);
  od = __builtin_amdgcn_mfma_f32_32x32x16_bf16(pa1, PK(l1, h1), od, 0, 0, 0);
  od = __builtin_amdgcn_mfma_f32_32x32x16_bf16(pa2, PK(l2, h2), od, 0, 0, 0);
  od = __builtin_amdgcn_mfma_f32_32x32x16_bf16(pa3, PK(l3, h3), od, 0, 0, 0);
#undef PK
}
DI void pv_d0(f32x16* o, int vb, bf16x8 pa0, bf16x8 pa1, bf16x8 pa2, bf16x8 pa3) {
  pv_one<0>(o[0], vb, pa0, pa1, pa2, pa3); pv_one<1>(o[1], vb, pa0, pa1, pa2, pa3); pv_one<2>(o[2], vb, pa0, pa1, pa2, pa3); pv_one<3>(o[3], vb, pa0, pa1, pa2, pa3);
}

template <bool BAND, int SD, bool ACT> DI void attn_unit_(const Unit& U, LAS char* lds, float C) {
  constexpr int NQ = BAND ? 8 : 12;
  int tid = threadIdx.x; asm volatile("" : "+v"(tid)); const int wid = __builtin_amdgcn_readfirstlane(tid >> 6), lane = tid & 63, r32 = lane & 31, hi = lane >> 5;
  LAS char* V_lds = lds + OFF_V; LAS char* K_lds = lds + OFF_K; LAS char* KR_lds = lds + OFF_KR;
  LAS float* wsf = (LAS float*)(lds + OFF_WS) + wid * 64; LAS float* li_l = wsf; LAS float* al_l = wsf + 32;
  LAS float* T3 = (LAS float*)(lds + OFF_BIAS);
  const int wq = wid & (U.nact - 1);
  const int cw = wid >> 1; const int t_hi = U.thi0 + cw; const int t_lo = (U.tlo0 + cw) > 0 ? (U.tlo0 + cw) : 0;
  float m_reg = -1e30f, l_reg = 0; f32x16 o[4] = {}; bf16x8 qr[NQ];
  if (ACT) {
    const bf16* Qw = U.Q + (size_t)(wq * 32 + r32) * U.ldq + hi * 8;
#pragma unroll
    for (int d0 = 0; d0 < 8; ++d0) qr[d0] = *(const bf16x8*)(Qw + d0 * 16);
    if (!BAND) { const bf16* Qw2 = U.Qr + (size_t)(wq * 32 + r32) * U.ldq + hi * 8;
#pragma unroll
      for (int d0 = 0; d0 < 4; ++d0) qr[(NQ == 12 ? 8 : 0) + d0] = *(const bf16x8*)(Qw2 + d0 * 16); }
  }
  if (BAND) { for (int j = tid; j < 640; j += 512) { int rel = 575 - j; rel = rel > 256 ? 256 : rel; T3[j] = U.bias[rel + 256] * LOG2E; } }
  const int sr = tid >> 4, sc = (tid & 15) * 8, vst0 = v_st(sr, sc), vst1 = v_st(32 + sr, sc);
  const int krr = tid >> 3, krc = (tid & 7) * 8;
  const int vb0 = (int)(uintptr_t)V_lds + v_rd_base(lane);
  const int jb0 = 575 - U.qrel0 - 32 * wq - r32 + 4 * hi;
  struct { bf16x8 vs0, vs1, ks0, ks1, kr; } sr_[SD];
  const int ntr = U.nt, NT = (U.nt + 1) & ~1;
  const unsigned vo0 = (unsigned)(sr * U.ldk + sc) * 2u, vo1 = (unsigned)((32 + sr) * U.ldk + sc) * 2u, vokr = (unsigned)(krr * 64 + krc) * 2u;
  const size_t tstep = (size_t)64 * U.ldk * 2;
#define SLOAD(i, t) do { const int tt_ = (t) < ntr ? (t) : ntr - 1; const char* kt_ = (const char*)U.K + tt_ * tstep; const char* vt_ = (const char*)U.V + tt_ * tstep;  \
    sr_[i].vs0 = *(const bf16x8*)(vt_ + vo0); sr_[i].vs1 = *(const bf16x8*)(vt_ + vo1);         \
    sr_[i].ks0 = *(const bf16x8*)(kt_ + vo0); sr_[i].ks1 = *(const bf16x8*)(kt_ + vo1);         \
    if (!BAND) sr_[i].kr = *(const bf16x8*)((const char*)U.KR + (size_t)tt_ * 8192 + vokr); } while (0)
#define SWRITE(b, i) do { *(LAS bf16x8*)(V_lds + (b) * SHM_V + vst0) = sr_[i].vs0; *(LAS bf16x8*)(V_lds + (b) * SHM_V + vst1) = sr_[i].vs1; \
    const int kc_ = sc * 2; *(LAS bf16x8*)(K_lds + (b) * SHM_K + KSWZ(sr, kc_)) = sr_[i].ks0; *(LAS bf16x8*)(K_lds + (b) * SHM_K + KSWZ(32 + sr, kc_)) = sr_[i].ks1; \
    if (!BAND) *(LAS bf16x8*)(KR_lds + (b) * SHM_KR + KRSWZ(krr, krc * 2)) = sr_[i].kr; } while (0)
#define SWAIT() do { if (SD == 2) asm volatile("s_waitcnt vmcnt(%0)" ::"n"(BAND ? 4 : 5) : "memory"); else asm volatile("s_waitcnt vmcnt(0)" ::: "memory"); } while (0)
#define RESC(a) do { if (__any((a) < 1.f)) { if (hi == 0) al_l[r32] = (a); asm volatile("s_waitcnt lgkmcnt(0)" ::: "memory"); \
    _Pragma("unroll") for (int d = 0; d < 4; ++d) _Pragma("unroll") for (int r = 0; r < 16; ++r) o[d][r] *= al_l[crow(r, hi)]; } } while (0)
#define MASKED(t) ((t) < t_lo || (t) > t_hi)
  f32x16 pA0, pA1, pB0, pB1; float mnA, mnB, alA = 1.f, alB = 1.f; bf16x8 pa0, pa1, pa2, pa3;
  { u32x4 zz = {0u, 0u, 0u, 0u}; asm volatile("" : "+v"(zz)); pa0 = pa1 = pa2 = pa3 = __builtin_bit_cast(bf16x8, zz); }
  constexpr int SE = 0, SO = SD - 1;
  SLOAD(SE, 0); if (SD == 2) SLOAD(SO, 1);
  if (SD == 2) asm volatile("s_waitcnt vmcnt(%0)" ::"n"(BAND ? 4 : 5) : "memory"); else asm volatile("s_waitcnt vmcnt(0)" ::: "memory");
  SWRITE(0, SE);
  if (SD == 2) { if (2 < NT) SLOAD(SE, 2); } else SLOAD(SO, 1);
  __syncthreads();
  if (ACT) { qkt<NQ>(pA0, pA1, K_lds, KR_lds, qr, r32, hi); partialSM<BAND>(pA0, pA1, m_reg, mnA, alA, MASKED(0), T3 + jb0, C); }
  SWAIT(); SWRITE(1, SO); __syncthreads();
  for (int j = 1; j + 1 < NT; j += 2) {
    SBAR();
    if (ACT) { qkt<NQ>(pB0, pB1, K_lds + SHM_K, KR_lds + SHM_KR, qr, r32, hi); finishSM(pA0, pA1, alA, l_reg, pa0, pa1, pa2, pa3); }
    SBAR();
    SLOAD(SO, j + SD); SBAR();
    if (ACT) { pv_d0(o, vb0, pa0, pa1, pa2, pa3); partialSM<BAND>(pB0, pB1, m_reg, mnB, alB, MASKED(j), T3 + jb0 + 64 * j, C); }
    __syncthreads(); SWAIT(); SWRITE(0, SE);
    if (ACT) RESC(alB);
    __syncthreads();
    SBAR();
    if (ACT) { qkt<NQ>(pA0, pA1, K_lds, KR_lds, qr, r32, hi); finishSM(pB0, pB1, alB, l_reg, pa0, pa1, pa2, pa3); }
    SBAR();
    if (SD == 1 || j + 3 < NT) SLOAD(SE, j + 1 + SD); SBAR();
    if (ACT) { pv_d0(o, vb0 + SHM_V, pa0, pa1, pa2, pa3); partialSM<BAND>(pA0, pA1, m_reg, mnA, alA, MASKED(j + 1), T3 + jb0 + 64 * (j + 1), C); }
    __syncthreads(); SWAIT(); SWRITE(1, SO);
    if (ACT) RESC(alA);
    __syncthreads();
  }
  SBAR();
  if (ACT) {
    qkt<NQ>(pB0, pB1, K_lds + SHM_K, KR_lds + SHM_KR, qr, r32, hi);
    finishSM(pA0, pA1, alA, l_reg, pa0, pa1, pa2, pa3); SBAR();
    pv_d0(o, vb0, pa0, pa1, pa2, pa3); partialSM<BAND>(pB0, pB1, m_reg, mnB, alB, MASKED(NT - 1), T3 + jb0 + 64 * (NT - 1), C);
  }
  __syncthreads();
  if (ACT) {
    RESC(alB);
    finishSM(pB0, pB1, alB, l_reg, pa0, pa1, pa2, pa3); SBAR();
    pv_d0(o, vb0 + SHM_V, pa0, pa1, pa2, pa3);
    if (hi == 0) li_l[r32] = l_reg; asm volatile("s_waitcnt lgkmcnt(0)" ::: "memory");
    float rli[16];
#pragma unroll
    for (int r = 0; r < 16; ++r) rli[r] = __builtin_amdgcn_rcpf(li_l[crow(r, hi)]);
    LAS char* stg = lds + (wid < 2 ? OFF_V + wid * 8192 : OFF_K + (wid - 2) * 8192);
#pragma unroll
    for (int r = 0; r < 16; ++r) { const int orow = crow(r, hi);
#pragma unroll
      for (int d0 = 0; d0 < 4; ++d0) *(LAS bf16*)(stg + orow * 256 + (d0 * 32 + r32) * 2) = (bf16)(cvtpk(o[d0][r] * rli[r], 0.f) & 0xffffu); }
    asm volatile("s_waitcnt lgkmcnt(0)" ::: "memory");
    bf16* Ow = U.O + (size_t)(wid * 32) * U.ldo;
#pragma unroll
    for (int i = 0; i < 8; ++i) { const int row = i * 4 + (lane >> 4), ch = lane & 15; const u32x4 v = *(const LAS u32x4*)(stg + row * 256 + ch * 16); *(u32x4*)(Ow + (size_t)row * U.ldo + ch * 8) = v; }
  }
  asm volatile("s_waitcnt vmcnt(0) lgkmcnt(0)" ::: "memory");
  __syncthreads();
#undef SLOAD
#undef SWRITE
#undef SWAIT
#undef RESC
#undef MASKED
}
template <bool BAND, int SD> DI void attn_unit(const Unit& U, LAS char* lds, float C) {
  const int wid = __builtin_amdgcn_readfirstlane((int)threadIdx.x >> 6);
  if (wid < U.nact) attn_unit_<BAND, SD, true>(U, lds, C); else attn_unit_<BAND, SD, false>(U, lds, C);
}
}
#define XB_TMO      128
#define XB_XCNT(j)  (256  + 64 * (j))
#define XB_XSUB(j)  (1280 + 64 * (j))
#define XB_XGEN(j)  (2304 + 64 * (j))
#define XB_TOP      3328
#define XB_TOPGEN   3392
#define XCD_BAR_WORDS 3456
#define XB_SPIN_CAP (1u << 18)

__device__ __forceinline__ unsigned xb_ld(unsigned* p)              { return __hip_atomic_load(p, __ATOMIC_RELAXED, __HIP_MEMORY_SCOPE_AGENT); }
__device__ __forceinline__ unsigned xb_add(unsigned* p, unsigned v) { return __hip_atomic_fetch_add(p, v, __ATOMIC_RELAXED, __HIP_MEMORY_SCOPE_AGENT); }
__device__ __forceinline__ unsigned xb_xcc_id() { return (unsigned)__builtin_amdgcn_s_getreg((3 << 11) | 20) & 0xFu; }
#define XB_SPIN(cond, bar) do { unsigned _sp = 0; while (cond) { __builtin_amdgcn_s_sleep(1); \
    if ((++_sp & 255u) == 0u) { if (xb_ld(&(bar)[XB_TMO])) break; if (_sp > XB_SPIN_CAP) { atomicAdd(&(bar)[XB_TMO], 1u); break; } } } } while (0)

struct XcdBarrier {
    unsigned* bar; unsigned x;
    volatile LAS unsigned* st;
};

__device__ __forceinline__ XcdBarrier xcd_barrier_post(unsigned* bar, volatile LAS unsigned* st) {
    XcdBarrier b; b.bar = bar; b.x = xb_xcc_id(); b.st = st;
    if (threadIdx.x == 0) (void)xb_add(&bar[XB_XCNT(b.x)], 1u);
    return b;
}
__device__ __forceinline__ void xcd_barrier_complete(unsigned* bar, unsigned x, unsigned& nloc, unsigned& nx) {
    const unsigned G = gridDim.x * gridDim.y * gridDim.z;
    unsigned sum, cnt, mine, sp = 0u;
    for (;;) {
        sum = 0u; cnt = 0u; mine = 0u;
#pragma unroll
        for (unsigned j = 0; j < 16; ++j) { const unsigned c = xb_ld(&bar[XB_XCNT(j)]); sum += c; cnt += (c > 0u) ? 1u : 0u; mine = (j == x) ? c : mine; }
        if (sum == G) break;
        __builtin_amdgcn_s_sleep(1);
        if ((++sp & 255u) == 0u) { if (xb_ld(&bar[XB_TMO])) break; if (sp > XB_SPIN_CAP) { atomicAdd(&bar[XB_TMO], 1u); break; } }
    }
    nloc = mine > 0u ? mine : 1u; nx = cnt > 0u ? cnt : 1u;
}

__device__ __forceinline__ void xcd_barrier(const XcdBarrier& b) {
    asm volatile("s_waitcnt vmcnt(0)" ::: "memory");
    __syncthreads();
    if (threadIdx.x == 0) {
        unsigned* bar = b.bar;
        __builtin_amdgcn_s_waitcnt(0);
        unsigned nloc = b.st[0], nx = b.st[1];
        if (nloc == 0u) { xcd_barrier_complete(bar, b.x, nloc, nx); b.st[0] = nloc; b.st[1] = nx; }
        const unsigned old = xb_add(&bar[XB_XSUB(b.x)], 1u);
        const unsigned gen = old / nloc;
        if (old + 1u == (gen + 1u) * nloc) {
            __builtin_amdgcn_fence(__ATOMIC_RELEASE, "agent");
            asm volatile("s_waitcnt vmcnt(0)" ::: "memory");
            const unsigned og = xb_add(&bar[XB_TOP], 1u);
            const unsigned tg = og / nx;
            if (og + 1u == (tg + 1u) * nx) xb_add(&bar[XB_TOPGEN], 1u);
            else XB_SPIN(xb_ld(&bar[XB_TOPGEN]) == tg, bar);
            __builtin_amdgcn_fence(__ATOMIC_ACQUIRE, "agent");
            xb_add(&bar[XB_XGEN(b.x)], 1u);
            asm volatile("s_waitcnt vmcnt(0)" ::: "memory");
        } else {
            XB_SPIN(xb_ld(&bar[XB_XGEN(b.x)]) == gen, bar);
            __builtin_amdgcn_fence(__ATOMIC_ACQUIRE, "agent");
            asm volatile("s_waitcnt vmcnt(0)" ::: "memory");
        }
    }
    __syncthreads();
}

#ifndef PROBE_PH
#define PROBE_PH 0
#endif
#ifndef PROBE_REP
#define PROBE_REP 0
#endif
#ifndef PROBE_SYNC
#define PROBE_SYNC 0
#endif
#ifndef BAND_SD
#define BAND_SD 2
#endif
#ifndef MLA_SD
#define MLA_SD 1
#endif
constexpr int NSTEPS = 20;
struct Args { const float* in[23]; float* out; unsigned char* ws; int ph_lo, ph_hi; };
constexpr int LDS_BYTES = 133120 + 1024;

typedef const __attribute__((address_space(4))) Args CArgs;
DI const float* xin_row(CArgs& a, int row) { return row < NPR ? a.in[0] + (size_t)row * DM : a.in[1] + (size_t)(row - NPR) * DM; }

DI bool get_gemm(int ph, bool tail8, CArgs& a, const bf16*& A, const bf16*& Bt, int& M, int& N, int& K, EpiMode& E) {
  unsigned char* ws = a.ws;
  E.mode = EM_BF16; E.O = nullptr; E.O2 = nullptr; E.ldc = 0; E.F = nullptr; E.outp = a.out; E.ws = ws;
  switch (ph) {
    case 1:  A = (const bf16*)(ws + A_H);    Bt = (const bf16*)(ws + W_QKV); M = MT; N = 6144; K = 2048; E.mode = EM_QKV; return true;
    case 3:  A = (const bf16*)(ws + A_O0);   Bt = (const bf16*)(ws + W_AO);  M = MT; N = 2048; K = 2048; E.O = (bf16*)(ws + A_T); E.ldc = 2048; if (tail8) { E.mode = EM_TAIL; E.O2 = (bf16*)(ws + A_Q0); } return true;
    case 5:  A = (const bf16*)(ws + A_H);    Bt = (const bf16*)(ws + W_F1);  M = MT; N = 8192; K = 2048; E.mode = EM_RELU2; E.O = (bf16*)(ws + A_HID); E.ldc = 8192; return true;
    case 6:  A = (const bf16*)(ws + A_HID);  Bt = (const bf16*)(ws + W_F2);  M = MT; N = 2048; K = 8192; E.mode = tail8 ? EM_TAIL : EM_SPLIT; E.O = (bf16*)(ws + A_T); E.O2 = (bf16*)(ws + (tail8 ? A_PF : A_H)); E.ldc = 2048; return true;
    case 8:  A = (const bf16*)(ws + A_H);    Bt = (const bf16*)(ws + W_D);   M = MT; N = 1280; K = 2048; E.mode = EM_F32; E.F = (float*)(ws + A_DQ); E.ldc = 1280; return true;
    case 10: A = (const bf16*)(ws + A_CQ);   Bt = (const bf16*)(ws + W_UQ);  M = MT; N = 3072; K = 512; E.mode = EM_QROPE; E.O = (bf16*)(ws + A_QM); E.ldc = 3072; return true;
    case 11: A = (const bf16*)(ws + A_CKVP); Bt = (const bf16*)(ws + W_UKV); M = NPR; N = 4096; K = 512; E.O = (bf16*)(ws + A_KNV); E.ldc = 4096; return true;
    case 13: A = (const bf16*)(ws + A_CKVS); Bt = (const bf16*)(ws + W_UKV); M = 33792; N = 4096; K = 512; E.O = (bf16*)(ws + A_KNV); E.ldc = 4096; return true;
    case 15: A = (const bf16*)(ws + A_O1);   Bt = (const bf16*)(ws + W_MO);  M = MT; N = 2048; K = 2048; E.O = (bf16*)(ws + A_T); E.ldc = 2048; if (tail8) { E.mode = EM_TAIL; E.O2 = (bf16*)(ws + A_QM); } return true;
    case 17: A = (const bf16*)(ws + A_H);    Bt = (const bf16*)(ws + W_F1);  M = MT; N = 8192; K = 2048; E.mode = EM_RELU2; E.O = (bf16*)(ws + A_HID); E.ldc = 8192; return true;
    case 18: A = (const bf16*)(ws + A_HID);  Bt = (const bf16*)(ws + W_F2);  M = MT; N = 2048; K = 8192; E.mode = tail8 ? EM_TAIL : EM_SPLIT; E.O = (bf16*)(ws + A_T); E.O2 = (bf16*)(ws + (tail8 ? A_PF : A_H)); E.ldc = 2048; return true;
    default: return false;
  }
}

__global__ void __launch_bounds__(512) fwd_mega(Args a_) {
  extern __shared__ __attribute__((aligned(16))) unsigned char lds_raw[];
  LAS unsigned char* lds = (LAS unsigned char*)lds_raw;
  cg::grid_group grid = cg::this_grid();
  if (threadIdx.x < 2) ((volatile LAS unsigned*)(lds + 133120))[threadIdx.x] = 0u;
  __syncthreads();
  const XcdBarrier xbar = xcd_barrier_post((unsigned*)(a_.ws + A_BAR), (volatile LAS unsigned*)(lds + 133120));
  for (int it_ = a_.ph_lo; it_ < a_.ph_hi; ++it_) {
    const int ph = it_ <= PROBE_PH ? it_ : (it_ <= PROBE_PH + PROBE_REP ? PROBE_PH : it_ - PROBE_REP);
    const __attribute__((address_space(4))) char* kp_ = (const __attribute__((address_space(4))) char*)__builtin_amdgcn_kernarg_segment_ptr();
    asm volatile("" : "+s"(kp_));
    CArgs& a = *(CArgs*)kp_;
    int tid = threadIdx.x; asm volatile("" : "+v"(tid));
    const int lane = tid & 63, wave = __builtin_amdgcn_readfirstlane(tid >> 6);
    const int G = gridDim.x, gw = blockIdx.x * 8 + wave, NGW = G * 8;
    const size_t gt = (size_t)blockIdx.x * 512 + tid, NGT = (size_t)G * 512;
    unsigned char* ws = a.ws; float* outp = a.out;
    const bf16* gA; const bf16* gB; int gM, gN, gK; EpiMode E;
    const bool tail8 = (G == 256);
    if (get_gemm(ph, tail8, a, gA, gB, gM, gN, gK, E)) {
#ifndef NO_GEMM
      run_gemm(lds, gA, gB, gM, gN, gK, E);
#endif
      if (ph == 1 || ph == 5 || ph == 8 || ph == 17) {
        const int nwg_ = (gM / 256) * (gN / 256), rem_ = nwg_ % G;
        int li_ = (int)blockIdx.x, nl_ = G;
        if (rem_ != 0) { li_ = (int)blockIdx.x - rem_; nl_ = li_ >= 0 ? G - rem_ : 0; }
        if (nl_ > 0) {
          LAS float* scr = (LAS float*)(lds + wave * 16640);
          const int w0 = li_ * 8 + wave, nw = nl_ * 8;
          if (ph == 1) {
            constexpr int I1 = 32 * 32, I2 = 32 * 8, I3 = 32 * 9, I4 = 8 * 48, I5 = 8 * 32, I6 = 8 * 32, I7 = 32 * 32, I8 = 32 * 128;
            constexpr int NIT = I1 + I2 + I3 + I4 + I5 + I6 + I7 + I8;
            for (int it = w0; it < NIT; it += nw) {
              int r = it;
              if (r < I1) { transpose_item<0>(a.in[11], 2048, 2048, (bf16*)(ws + W_AO), 0, scr, r, lane); continue; } r -= I1;
              if (r < I2) { transpose_item<0>(a.in[13], 2048, 512, (bf16*)(ws + W_D), 0, scr, r, lane); continue; } r -= I2;
              if (r < I3) { transpose_item<0>(a.in[16], 2048, 576, (bf16*)(ws + W_D), 512, scr, r, lane); continue; } r -= I3;
              if (r < I4) { transpose_item<1>(a.in[15], 512, 3072, (bf16*)(ws + W_UQ), 0, scr, r, lane); continue; } r -= I4;
              if (r < I5) { transpose_item<0>(a.in[18], 512, 2048, (bf16*)(ws + W_UKV), 0, scr, r, lane); continue; } r -= I5;
              if (r < I6) { transpose_item<0>(a.in[19], 512, 2048, (bf16*)(ws + W_UKV), 2048, scr, r, lane); continue; } r -= I6;
              if (r < I7) { transpose_item<0>(a.in[20], 2048, 2048, (bf16*)(ws + W_MO), 0, scr, r, lane); continue; } r -= I7;
              transpose_item<0>(a.in[21], 2048, 8192, (bf16*)(ws + W_F1), 0, scr, r, lane);
            }
          } else if (ph == 5) {
            for (int it = w0; it < 128 * 32; it += nw) transpose_item<0>(a.in[22], 8192, 2048, (bf16*)(ws + W_F2), 0, scr, it, lane);
          } else if (ph == 8) {
            for (int it = w0; it < 32 * 128; it += nw) transpose_item<0>(a.in[21] + (size_t)2048 * 8192, 2048, 8192, (bf16*)(ws + W_F1), 0, scr, it, lane);
          } else {
            for (int it = w0; it < 128 * 32; it += nw) transpose_item<0>(a.in[22] + (size_t)2048 * 8192, 8192, 2048, (bf16*)(ws + W_F2), 0, scr, it, lane);
          }
        }
      }
    } else if (ph == 0 || ph == 7) {
      LAS float* scr = (LAS float*)(lds + wave * 16640);
      if (ph == 0) {
        for (int it = gw; it < 32 * 96; it += NGW) transpose_item<0>(a.in[10], 2048, 6144, (bf16*)(ws + W_QKV), 0, scr, it, lane);
        { u32x4* z = (u32x4*)((bf16*)(ws + W_D) + (size_t)1088 * 2048); const size_t n16 = (size_t)192 * 2048 * 2 / 16;
          u32x4 zv = {0u, 0u, 0u, 0u}; asm volatile("" : "+v"(zv));
          for (size_t i = gt; i < n16; i += NGT) z[i] = zv; }
        { const size_t ng = (size_t)16 * 512 * 256;
#define CVT_A_LD(i, va, vb) const int isv##va = (i) >= ng; const size_t g##va = isv##va ? (i) - ng : (i); const float* s##va = a.in[isv##va ? 3 : 2] + g##va * 8; const f32x4 va = *(const f32x4*)s##va, vb = *(const f32x4*)(s##va + 4)
#define CVT_A_ST(va, vb) *(u32x4*)((bf16*)(ws + (isv##va ? A_VS : A_KS)) + (g##va / (512 * 256)) * 576 * 2048 + (g##va % (512 * 256)) * 8) = pack8(va, vb)
          size_t i = gt;
          for (; i + 3 * NGT < 2 * ng; i += 4 * NGT) { CVT_A_LD(i, p0, p1); CVT_A_LD(i + NGT, q0, q1); CVT_A_LD(i + 2 * NGT, r0, r1); CVT_A_LD(i + 3 * NGT, t0, t1);
            CVT_A_ST(p0, p1); CVT_A_ST(q0, q1); CVT_A_ST(r0, r1); CVT_A_ST(t0, t1); }
          for (; i < 2 * ng; i += NGT) { CVT_A_LD(i, p0, p1); CVT_A_ST(p0, p1); }
#undef CVT_A_LD
#undef CVT_A_ST
        }
        for (int m = gw; m < MT; m += NGW) row_norm_to_bf16(xin_row(a, m), a.in[6], (bf16*)(ws + A_H) + (size_t)m * DM, xb_row(outp, m), lane);
      } else {
        for (int m = gw; m < MT; m += NGW)
          row_resid_norm<true, true>((const bf16*)(ws + A_T) + (size_t)m * DM, tail8 ? (const bf16*)(ws + A_PF) + (size_t)(m - NPR) * DM : (const bf16*)(ws + A_H) + (size_t)m * DM, tail8 ? (m < NPR ? 0 : 8) : 1, xb_row(outp, m), xb_row(outp, m), a.in[9], a.in[6] + DM, (bf16*)(ws + A_H) + (size_t)m * DM, lane);
      }
    } else if (ph == 4) {
      for (int m = gw; m < MT; m += NGW)
        row_resid_norm<true, true>((const bf16*)(ws + A_T) + (size_t)m * DM, (const bf16*)(ws + A_Q0) + (size_t)(m - NPR) * DM, (tail8 && m >= NPR) ? 8 : 0, xb_row(outp, m), xb_row(outp, m), a.in[7], a.in[8], (bf16*)(ws + A_H) + (size_t)m * DM, lane);
    } else if (ph == 16) {
      for (int m = gw; m < MT; m += NGW)
        row_resid_norm<true, true>((const bf16*)(ws + A_T) + (size_t)m * DM, (const bf16*)(ws + A_QM) + (size_t)(m - NPR) * DM, (tail8 && m >= NPR) ? 8 : 0, xb_row(outp, m), xb_row(outp, m), a.in[7] + DM, a.in[8] + DM, (bf16*)(ws + A_H) + (size_t)m * DM, lane);
    } else if (ph == 19) {
      for (int m = gw; m < MT; m += NGW)
        row_resid_norm<true, false>((const bf16*)(ws + A_T) + (size_t)m * DM, tail8 ? (const bf16*)(ws + A_PF) + (size_t)(m - NPR) * DM : (const bf16*)(ws + A_H) + (size_t)m * DM, tail8 ? (m < NPR ? 0 : 8) : 1, xb_row(outp, m), outp + (size_t)m * DM, a.in[9] + DM, nullptr, nullptr, lane);
    } else if (ph == 9) {
      for (int m = gw; m < MT; m += NGW) row_mla((const bf16*)(ws + A_DQ) + (size_t)m * 1280, m, a.in[14], a.in[17], ws, outp, lane);
      { const size_t ng = (size_t)16 * 2048 * 64;
#define CVT_C_LD(i, va, vb) const size_t g##va = (i); const float* s##va = a.in[4] + g##va * 8; const f32x4 va = *(const f32x4*)s##va, vb = *(const f32x4*)(s##va + 4)
#define CVT_C_ST(va, vb) *(u32x4*)((bf16*)(ws + A_CKVS) + (g##va / (2048 * 64)) * 2112 * 512 + (g##va % (2048 * 64)) * 8) = pack8(va, vb)
        size_t i = gt;
        for (; i + 3 * NGT < ng; i += 4 * NGT) { CVT_C_LD(i, p0, p1); CVT_C_LD(i + NGT, q0, q1); CVT_C_LD(i + 2 * NGT, r0, r1); CVT_C_LD(i + 3 * NGT, t0, t1);
          CVT_C_ST(p0, p1); CVT_C_ST(q0, q1); CVT_C_ST(r0, r1); CVT_C_ST(t0, t1); }
        for (; i < ng; i += NGT) { CVT_C_LD(i, p0, p1); CVT_C_ST(p0, p1); }
#undef CVT_C_LD
#undef CVT_C_ST
      }
      { const size_t ng = (size_t)16 * 2048 * 8;
        for (size_t i = gt; i < ng; i += NGT) { const size_t rowi = i >> 3; const int q = (int)(i & 7); const size_t b = rowi / 2048, r = rowi % 2048;
          const float* src = a.in[5] + rowi * 64 + 4 * q; const f32x4 x1 = *(const f32x4*)src, x2 = *(const f32x4*)(src + 32);
          u32x4 w; w.x = cvtpk(x1.x, x2.x); w.y = cvtpk(x1.y, x2.y); w.z = cvtpk(x1.z, x2.z); w.w = cvtpk(x1.w, x2.w);
          *(u32x4*)((bf16*)(ws + A_KRS) + (b * 2112 + r) * 64 + 8 * q) = w; } }
    } else if (ph == 2) {
      const float C = 0.08838834764831845f * LOG2E;
      for (int u = blockIdx.x; u < 1280; u += G) {
        att::Unit U; U.Qr = nullptr; U.KR = nullptr; U.ldq = 2048; U.ldk = 2048; U.ldo = 2048;
        if (u < 1024) { const int h = u & 15, qb = (u >> 4) & 15, b = u >> 8, c0 = qb * 4, kc0 = c0 > 8 ? c0 - 8 : 0;
          const size_t rq = (size_t)b * 4096 + qb * 256, rk = (size_t)b * 4096 + kc0 * 64;
          U.Q = (const bf16*)(ws + A_Q0) + rq * 2048 + h * 128; U.K = (const bf16*)(ws + A_KP) + rk * 2048 + h * 128; U.V = (const bf16*)(ws + A_VP) + rk * 2048 + h * 128;
          U.O = (bf16*)(ws + A_O0) + rq * 2048 + h * 128; U.nt = c0 + 4 - kc0; U.nact = 8; U.thi0 = c0 - kc0; U.tlo0 = c0 - 8 - kc0; U.qrel0 = (c0 - kc0) * 64; U.bias = a.in[12] + h * 513;
        } else { const int us = u - 1024, h = us & 15, b = us >> 4; const size_t rq = (size_t)NPR + b * 64;
          U.Q = (const bf16*)(ws + A_Q0) + rq * 2048 + h * 128; U.K = (const bf16*)(ws + A_KS) + (size_t)b * 576 * 2048 + h * 128; U.V = (const bf16*)(ws + A_VS) + (size_t)b * 576 * 2048 + h * 128;
          U.O = (bf16*)(ws + A_O0) + rq * 2048 + h * 128; U.nt = 9; U.nact = 2; U.thi0 = 8; U.tlo0 = 0; U.qrel0 = 512; U.bias = a.in[12] + h * 513; }
#ifndef NO_BAND
        att::attn_unit<true, BAND_SD>(U, (LAS char*)lds, C);
#endif
      }
    } else if (ph == 12 || ph == 14) {
      const float C = 0.07216878364870322f * LOG2E;
      const int nunits = ph == 12 ? 1024 : 256;
      for (int i = blockIdx.x; i < nunits; i += G) {
        att::Unit U; U.ldq = 3072; U.ldk = 4096; U.ldo = 2048; U.bias = nullptr; U.qrel0 = 0; U.tlo0 = -100000;
        if (ph == 12) { const int rnd = i >> 8, v = i & 255, bh = v >> 2, s = v & 3, qb = rnd == 0 ? s : rnd == 1 ? 7 - s : rnd == 2 ? 8 + s : 15 - s, b = bh >> 4, h = bh & 15;
          const size_t rq = (size_t)b * 4096 + qb * 256, rk = (size_t)b * 4096;
          U.Q = (const bf16*)(ws + A_QM) + rq * 3072 + h * 128; U.Qr = (const bf16*)(ws + A_QM) + rq * 3072 + 2048 + h * 64;
          U.K = (const bf16*)(ws + A_KNV) + rk * 4096 + h * 128; U.V = (const bf16*)(ws + A_KNV) + rk * 4096 + 2048 + h * 128; U.KR = (const bf16*)(ws + A_KRP) + rk * 64;
          U.O = (bf16*)(ws + A_O1) + rq * 2048 + h * 128; U.nt = qb * 4 + 4; U.nact = 8; U.thi0 = qb * 4;
        } else { const int b = i >> 4, h = i & 15; const size_t rq = (size_t)NPR + b * 64, rk = (size_t)b * 2112;
          U.Q = (const bf16*)(ws + A_QM) + rq * 3072 + h * 128; U.Qr = (const bf16*)(ws + A_QM) + rq * 3072 + 2048 + h * 64;
          U.K = (const bf16*)(ws + A_KNV) + rk * 4096 + h * 128; U.V = (const bf16*)(ws + A_KNV) + rk * 4096 + 2048 + h * 128; U.KR = (const bf16*)(ws + A_KRS) + rk * 64;
          U.O = (bf16*)(ws + A_O1) + rq * 2048 + h * 128; U.nt = 33; U.nact = 2; U.thi0 = 32; }
#ifndef NO_MLA
        att::attn_unit<false, MLA_SD>(U, (LAS char*)lds, C);
#endif
      }
    }
    if (it_ + 1 < a_.ph_hi && ph != 10) { if (a_.ph_hi > 1000) grid.sync(); else xcd_barrier(xbar);
      for (int e_ = 0; e_ < PROBE_SYNC; ++e_) xcd_barrier(xbar); }
  }
}

#ifndef MULTI_LAUNCH
#define MULTI_LAUNCH 0
#endif
extern "C" void kernel_launch(void* const* d_in, const int* in_sizes, int n_in, void* d_out, int out_size, void* d_ws, size_t ws_size, hipStream_t stream) {
  static int grid = 0;
  if (grid == 0) {
    if (n_in != 23 || out_size != (int)O_END || ws_size < WS_NEED) { fprintf(stderr, "kernel_launch: unexpected shapes n_in %d out %d ws %zu (need %zu)\n", n_in, out_size, ws_size, (size_t)WS_NEED); grid = -1; return; }
    int dev = 0, cus = 0, per_cu = 0;
    hipGetDevice(&dev); hipDeviceGetAttribute(&cus, hipDeviceAttributeMultiprocessorCount, dev);
    if (hipFuncSetAttribute((const void*)fwd_mega, hipFuncAttributeMaxDynamicSharedMemorySize, LDS_BYTES) != hipSuccess) { fprintf(stderr, "hipFuncSetAttribute failed\n"); grid = -1; return; }
    hipOccupancyMaxActiveBlocksPerMultiprocessor(&per_cu, (const void*)fwd_mega, 512, LDS_BYTES);
    (void)hipGetLastError();
    if (per_cu < 1) per_cu = 1;
    grid = cus;
  }
  if (grid < 0) return;
  if (hipMemsetAsync((char*)d_ws + A_BAR, 0, 16384, stream) != hipSuccess) { fprintf(stderr, "memset failed\n"); return; }
  Args a{};
  for (int i = 0; i < 23; ++i) a.in[i] = (const float*)d_in[i];
  a.out = (float*)d_out; a.ws = (unsigned char*)d_ws;
#if MULTI_LAUNCH
  for (int ph = 0; ph < NSTEPS; ++ph) { a.ph_lo = ph; a.ph_hi = ph + 1; hipLaunchKernelGGL(fwd_mega, dim3(grid), dim3(512), LDS_BYTES, stream, a); }
#else
  a.ph_lo = 0; a.ph_hi = NSTEPS + PROBE_REP;
  void* args[] = {&a};
  hipError_t e = hipLaunchCooperativeKernel((const void*)fwd_mega, dim3(grid), dim3(512), args, LDS_BYTES, stream);
  if (e != hipSuccess) fprintf(stderr, "cooperative launch failed: %s (grid %d)\n", hipGetErrorString(e), grid);
#endif
}
```

```cpp
#include <hip/hip_runtime.h>
#include <hip/hip_cooperative_groups.h>
#include <cstdio>
#include <cstdint>
namespace cg = cooperative_groups;
namespace pg8 {
#define PG8_LAS __attribute__((address_space(3)))
typedef unsigned short bf16_t;
typedef short bf16x8 __attribute__((ext_vector_type(8)));
typedef float f32x4 __attribute__((ext_vector_type(4)));
typedef unsigned u32x4 __attribute__((ext_vector_type(4)));
constexpr int BM = 256, BK = 64, HALF = 128, HTB = HALF * BK * 2  , STAGE_BYTES = 8 * HTB, NXCD = 8, WGM = 8;

__host__ __device__ __forceinline__ int lds_byte(int r, int c) { const int st = (r >> 4) * 2 + (c >> 5), rr = r & 15, cc = c & 31, ob = rr * 64 + cc * 2; return st * 1024 + (ob ^ (((ob >> 9) & 1) << 5)); }
__host__ __device__ __forceinline__ void stage_rc(int b, int& R, int& C) { const int st = b / 1024, sb = b % 1024, swz = sb ^ (((sb >> 9) & 1) << 5); R = (st >> 1) * 16 + swz / 64; C = (st & 1) * 32 + (swz % 64) / 2; }
__host__ __device__ __forceinline__ int perm32(int rho) { const int n = rho >> 4, i = rho & 15; return 8 * (i >> 2) + 4 * n + (i & 3); }

struct Unit { int pm, pn, kb, nk, part; };
struct Gemm { const bf16_t* A; const bf16_t* Bt; int M, N, K, lda; };

struct StaticOrder {
    int nM, nN, nwg, G, c, KT, ns;
    __host__ __device__ __forceinline__ void init(int M, int N, int K, int G_, int c_, int ns_) { nM = M / BM; nN = N / BM; nwg = nM * nN; G = G_; c = c_; KT = K / BK; ns = ns_; }
    __host__ __device__ __forceinline__ bool next(int i, Unit& uo) const {
        if (ns == 8) {
            const int L = i * G + c; Unit u;
            if (L < 512) {
                int wgid = L; { const int q = 512 / NXCD, xcd = wgid % NXCD, off = wgid / NXCD; wgid = xcd * q + off; }
                const int nig = WGM * nN; const int gid = wgid / nig, fm = gid * WGM;
                u.pm = fm + ((wgid % nig) % WGM); u.pn = (wgid % nig) / WGM; u.kb = 0; u.nk = KT; u.part = 2;
            } else {
                const int q = L - 512, t = q % 32, kp = q / 32;
                u.pm = 64 + t / 8; u.pn = t % 8; u.nk = KT / 8; u.kb = kp * u.nk; u.part = 16 + kp;
            }
            uo = u; return L < 768;
        }
        const int np = nwg * ns;
        const int L = i * G + c; const bool ok = L < np;
        int wgid = L; { const int q = np / NXCD, r = np % NXCD, xcd = wgid % NXCD, off = wgid / NXCD; wgid = (xcd < r ? xcd * (q + 1) : r * (q + 1) + (xcd - r) * q) + off; }
        const int half = wgid >= nwg ? 1 : 0; wgid -= half * nwg;
        const int nig = WGM * nN, gid = wgid / nig, fm = gid * WGM, gsz = (nM - fm) < WGM ? (nM - fm) : WGM;
        Unit u; u.pm = fm + ((wgid % nig) % gsz); u.pn = (wgid % nig) / gsz; u.nk = KT / ns; u.kb = half * u.nk; u.part = ns == 2 ? half : 2;
        uo = u; return ok;
    }
    __device__ __forceinline__ void a_ready(const Unit&) const {}
    __device__ __forceinline__ void done(const Unit&) const {}
};
__device__ __forceinline__ unsigned cvt_pk_bf16(float lo, float hi) { unsigned r; asm volatile("v_cvt_pk_bf16_f32 %0, %1, %2" : "=v"(r) : "v"(lo), "v"(hi)); return r; }
template <class Epi, class Sched, bool ALIGN_EPI = false, bool SP2 = false>
__device__ __forceinline__ void gemm_phase(PG8_LAS unsigned char* lds, const Gemm g, const Sched& S, const Epi& E) {
    int tid = threadIdx.x; asm volatile("" : "+v"(tid)); const int wid = __builtin_amdgcn_readfirstlane(tid >> 6), lane = tid & 63, wr = wid >> 2, wc = wid & 3, fr = lane & 15, fq = lane >> 4;
    const int K = g.K;
    unsigned voffA[2], voffB[2];
#pragma unroll
    for (int i = 0; i < 2; ++i) { int R, C; stage_rc(tid * 16 + i * 8192, R, C); const int Rb = Epi::PERM ? ((R & ~31) + perm32(R & 31)) : R;
        voffA[i] = (unsigned)(R * g.lda + C) * 2u; voffB[i] = (unsigned)(Rb * K + C) * 2u; }
    const size_t kstep = (size_t)(BK * 2);
    const size_t hstep = (size_t)HALF * K * 2;
    const size_t tstep = 2 * hstep;
    const size_t hstepA = (size_t)HALF * g.lda * 2, tstepA = 2 * hstepA;
    const unsigned ldsw = (unsigned)wid * 1024u;
    const int aoff = lds_byte(wr * 64 + fr, fq * 8), boff = lds_byte(wc * 32 + fr, fq * 8);
#define PG8_SA(b, h) (((b) * 2 + (h)) * HTB)
#define PG8_SB(b, h) ((4 + (b) * 2 + (h)) * HTB)
#define PG8_STAGE(bufoff, gbase, voff) do { _Pragma("unroll") for (int _i = 0; _i < 2; ++_i) \
        __builtin_amdgcn_global_load_lds((const unsigned*)((const char*)(gbase) + (voff)[_i]), (PG8_LAS unsigned*)(lds + (bufoff) + ldsw + _i * 8192), 16, 0, 0); } while (0)
#define PG8_LDA(dst, b, h) do { _Pragma("unroll") for (int m = 0; m < 4; ++m) _Pragma("unroll") for (int k = 0; k < 2; ++k) dst[m][k] = *(const PG8_LAS bf16x8*)(lds + PG8_SA(b, h) + aoff + m * 2048 + k * 1024); } while (0)
#define PG8_LDB(dst, b, h) do { _Pragma("unroll") for (int n = 0; n < 2; ++n) _Pragma("unroll") for (int k = 0; k < 2; ++k) dst[n][k] = *(const PG8_LAS bf16x8*)(lds + PG8_SB(b, h) + boff + n * 2048 + k * 1024); } while (0)
#define PG8_MMA(ai, bj, At, Bt) do { __builtin_amdgcn_s_setprio(1); _Pragma("unroll") for (int m = 0; m < 4; ++m) _Pragma("unroll") for (int n = 0; n < 2; ++n) _Pragma("unroll") for (int k = 0; k < 2; ++k) \
        acc[ai][bj][m][n] = __builtin_amdgcn_mfma_f32_16x16x32_bf16(Bt[n][k], At[m][k], acc[ai][bj][m][n], 0, 0, 0); __builtin_amdgcn_s_setprio(0); } while (0)
#define PG8_WAIT_V(n) asm volatile("s_waitcnt vmcnt(" #n ")" ::: "memory")
#define PG8_WAIT_L(n) asm volatile("s_waitcnt lgkmcnt(" #n ")" ::: "memory")
#define PG8_BAR __builtin_amdgcn_s_barrier()
#define PG8_SCHED __builtin_amdgcn_sched_barrier(0)
    Unit cur, nxt; int ui = 0;
    if (!S.next(0, cur)) return;
    f32x4 acc[2][2][4][2];
#pragma unroll
    for (int a = 0; a < 2; ++a)
#pragma unroll
        for (int b = 0; b < 2; ++b)
#pragma unroll
            for (int m = 0; m < 4; ++m)
#pragma unroll
                for (int n = 0; n < 2; ++n) acc[a][b][m][n] = (f32x4){0.f, 0.f, 0.f, 0.f};
    bf16x8 At[4][2], B0[2][2], B1[2][2];
    const char* cA = (const char*)g.A + (size_t)cur.pm * tstepA + (size_t)cur.kb * kstep; const char* cB = (const char*)g.Bt + (size_t)cur.pn * tstep + (size_t)cur.kb * kstep;
    S.a_ready(cur);
    if constexpr (SP2) {
        PG8_STAGE(PG8_SB(0, 0), cB, voffB); PG8_STAGE(PG8_SB(0, 1), cB + hstep, voffB); PG8_STAGE(PG8_SA(0, 0), cA, voffA); PG8_STAGE(PG8_SA(0, 1), cA + hstepA, voffA);
        if (wr == 1) PG8_BAR;
        PG8_WAIT_V(2); PG8_BAR;
        PG8_STAGE(PG8_SB(1, 0), cB + kstep, voffB); PG8_STAGE(PG8_SA(1, 0), cA + kstep, voffA); PG8_STAGE(PG8_SB(1, 1), cB + hstep + kstep, voffB);
        PG8_WAIT_V(6); PG8_BAR;
    } else {
        PG8_STAGE(PG8_SB(0, 0), cB, voffB); PG8_STAGE(PG8_SA(0, 0), cA, voffA); PG8_STAGE(PG8_SB(0, 1), cB + hstep, voffB); PG8_STAGE(PG8_SA(0, 1), cA + hstepA, voffA);
        if (wr == 1) PG8_BAR;
        PG8_WAIT_V(4); PG8_BAR;
        PG8_STAGE(PG8_SB(1, 0), cB + kstep, voffB); PG8_STAGE(PG8_SA(1, 0), cA + kstep, voffA); PG8_STAGE(PG8_SB(1, 1), cB + hstep + kstep, voffB);
        PG8_WAIT_V(6); PG8_BAR;
    }
    for (;;) {
        const bool has_next = S.next(ui + 1, nxt);
        const char* nA = has_next ? (const char*)g.A + (size_t)nxt.pm * tstepA + (size_t)nxt.kb * kstep : cA; const char* nB = has_next ? (const char*)g.Bt + (size_t)nxt.pn * tstep + (size_t)nxt.kb * kstep : cB;
        const int nt = cur.nk;
        for (int t = 0; t < nt; t += 2) {
            const bool last = (t == nt - 2);
            const char* a1 = cA + (size_t)(t + 1) * kstep;
            const char* a2 = last ? nA : cA + (size_t)(t + 2) * kstep; const char* b2 = last ? nB : cB + (size_t)(t + 2) * kstep;
            const char* a3 = a2 + kstep; const char* b3 = b2 + kstep;
            if (last && has_next) S.a_ready(nxt);
            if constexpr (SP2) {
            PG8_LDB(B0, 0, 0); PG8_LDB(B1, 0, 1); PG8_SCHED; PG8_LDA(At, 0, 0); PG8_STAGE(PG8_SA(1, 1), a1 + hstepA, voffA);
            PG8_WAIT_V(8); PG8_WAIT_L(0); PG8_BAR; PG8_MMA(0, 0, At, B0); PG8_MMA(0, 1, At, B1); PG8_BAR; PG8_SCHED;
            PG8_LDA(At, 0, 1); PG8_STAGE(PG8_SB(0, 0), b2, voffB); PG8_STAGE(PG8_SB(0, 1), b2 + hstep, voffB); PG8_STAGE(PG8_SA(0, 0), a2, voffA);
            PG8_WAIT_V(8); PG8_WAIT_L(0); PG8_BAR; PG8_MMA(1, 0, At, B0); PG8_MMA(1, 1, At, B1); PG8_BAR; PG8_SCHED;
            PG8_LDB(B0, 1, 0); PG8_LDB(B1, 1, 1); PG8_SCHED; PG8_LDA(At, 1, 0); PG8_STAGE(PG8_SA(0, 1), a2 + hstepA, voffA);
            PG8_WAIT_V(8); PG8_WAIT_L(0); PG8_BAR; PG8_MMA(0, 0, At, B0); PG8_MMA(0, 1, At, B1); PG8_BAR; PG8_SCHED;
            PG8_LDA(At, 1, 1); PG8_STAGE(PG8_SB(1, 0), b3, voffB); PG8_STAGE(PG8_SB(1, 1), b3 + hstep, voffB); PG8_STAGE(PG8_SA(1, 0), a3, voffA);
            PG8_WAIT_V(8); PG8_WAIT_L(0); PG8_BAR; PG8_MMA(1, 0, At, B0); PG8_MMA(1, 1, At, B1); PG8_BAR; PG8_SCHED;
            } else {
            PG8_LDB(B0, 0, 0); PG8_SCHED; PG8_LDA(At, 0, 0); PG8_STAGE(PG8_SA(1, 1), a1 + hstepA, voffA);
            PG8_WAIT_L(8); PG8_BAR; PG8_WAIT_L(0); PG8_MMA(0, 0, At, B0); PG8_BAR; PG8_SCHED;
            PG8_LDB(B1, 0, 1); PG8_STAGE(PG8_SB(0, 0), b2, voffB);
            PG8_BAR; PG8_WAIT_L(0); PG8_MMA(0, 1, At, B1); PG8_BAR;
            PG8_LDA(At, 0, 1); PG8_STAGE(PG8_SA(0, 0), a2, voffA);
            PG8_BAR; PG8_WAIT_L(0); PG8_MMA(1, 0, At, B0); PG8_BAR; PG8_SCHED;
            PG8_STAGE(PG8_SB(0, 1), b2 + hstep, voffB);
            PG8_WAIT_V(6); PG8_BAR; PG8_MMA(1, 1, At, B1); PG8_BAR;
            PG8_LDB(B0, 1, 0); PG8_SCHED; PG8_LDA(At, 1, 0); PG8_STAGE(PG8_SA(0, 1), a2 + hstepA, voffA);
            PG8_WAIT_L(8); PG8_BAR; PG8_WAIT_L(0); PG8_MMA(0, 0, At, B0); PG8_BAR; PG8_SCHED;
            PG8_LDB(B1, 1, 1); PG8_STAGE(PG8_SB(1, 0), b3, voffB);
            PG8_BAR; PG8_WAIT_L(0); PG8_MMA(0, 1, At, B1); PG8_BAR;
            PG8_LDA(At, 1, 1); PG8_STAGE(PG8_SA(1, 0), a3, voffA);
            PG8_BAR; PG8_WAIT_L(0); PG8_MMA(1, 0, At, B0); PG8_BAR; PG8_SCHED;
            PG8_STAGE(PG8_SB(1, 1), b3 + hstep, voffB);
            PG8_WAIT_V(6); PG8_BAR; PG8_MMA(1, 1, At, B1); PG8_BAR;
            }
        }
        if constexpr (ALIGN_EPI) { if (wr == 0) PG8_BAR; }
        if constexpr (!Epi::AFTER_DRAIN) { E(acc, cur, wr, wc, fr, fq); S.done(cur); }
        if (!has_next) break;
#pragma unroll
        for (int a = 0; a < 2; ++a)
#pragma unroll
            for (int b = 0; b < 2; ++b)
#pragma unroll
                for (int m = 0; m < 4; ++m)
#pragma unroll
                    for (int n = 0; n < 2; ++n) acc[a][b][m][n] = (f32x4){0.f, 0.f, 0.f, 0.f};
        cur = nxt; cA = nA; cB = nB; ++ui;
        if constexpr (ALIGN_EPI) { if (wr == 1) PG8_BAR; }
    }
    PG8_WAIT_V(0);
    if constexpr (!ALIGN_EPI) { if (wr == 0) PG8_BAR; }
    PG8_BAR;
    if constexpr (Epi::AFTER_DRAIN) { E.fused(acc, cur, wr, wc, fr, fq, lds, wid, lane); S.done(cur); }
#undef PG8_SA
#undef PG8_SB
#undef PG8_STAGE
#undef PG8_LDA
#undef PG8_LDB
#undef PG8_MMA
#undef PG8_WAIT_V
#undef PG8_WAIT_L
#undef PG8_BAR
#undef PG8_SCHED
}
}
#define LAS __attribute__((address_space(3)))
#define DI __device__ __forceinline__
typedef unsigned short bf16;
typedef float f32x4 __attribute__((ext_vector_type(4)));
typedef float f32x8 __attribute__((ext_vector_type(8)));
typedef float f32x16 __attribute__((ext_vector_type(16)));
typedef short bf16x8 __attribute__((ext_vector_type(8)));
typedef short s16x4 __attribute__((ext_vector_type(4)));
typedef unsigned u32x4 __attribute__((ext_vector_type(4)));
typedef unsigned u32x2 __attribute__((ext_vector_type(2)));

constexpr int DM = 2048, NPR = 16384, NSA = 1024, MT = NPR + NSA, SEQ = 4096, DEC = 64, PAST = 2048, DFF = 8192;
constexpr float EPS = 1e-6f;
constexpr float LOG2E = 1.4426950408889634f;

constexpr size_t O_Y = 0, O_AKP = 35651584, O_AVP = 39845888, O_AKS = 44040192, O_AVS = 46137344,
                 O_CKVP = 48234496, O_KRP = 56623104, O_CKVS = 57671680, O_KRS = 58195968, O_END = 58261504;
constexpr size_t MiB = 1u << 20;
constexpr size_t W_QKV = 0, W_AO = 24 * MiB, W_D = 32 * MiB, W_UQ = 37 * MiB, W_UKV = 40 * MiB, W_MO = 44 * MiB, W_F1 = 52 * MiB, W_F2 = 84 * MiB;
constexpr size_t A_H = 116 * MiB, A_T = 184 * MiB, A_R = 252 * MiB;
constexpr size_t A_Q0 = A_R, A_KP = A_R + 68 * MiB, A_VP = A_KP + 64 * MiB, A_KS = A_VP + 64 * MiB, A_VS = A_KS + 36 * MiB, A_O0 = A_VS + 36 * MiB;
constexpr size_t A_PF = 528 * MiB;
constexpr size_t A_HID = A_R;
constexpr size_t A_CKVP = A_R, A_CKVS = A_R + 16 * MiB, A_KRP = A_CKVS + 33 * MiB, A_KRS = A_KRP + 2 * MiB, A_QM = A_KRS + 5 * MiB, A_KNV = A_QM + 102 * MiB;
constexpr size_t A_DQ = A_KNV, A_CQ = A_KNV + 130 * MiB, A_O1 = A_H;
constexpr size_t A_BAR = A_KNV + 264 * MiB;
constexpr size_t A_RSTD = A_BAR + 65536;
constexpr size_t WS_NEED = A_RSTD + 131072;

DI unsigned cvtpk(float lo, float hi) { unsigned r; asm volatile("v_cvt_pk_bf16_f32 %0, %1, %2" : "=v"(r) : "v"(lo), "v"(hi)); return r; }
DI float bflo(unsigned w) { return __uint_as_float(w << 16); }
DI float bfhi(unsigned w) { return __uint_as_float(w & 0xffff0000u); }
DI float wave_sum(float v) {
  v += __int_as_float(__builtin_amdgcn_ds_swizzle(__float_as_int(v), (1 << 10) | 0x1f));
  v += __int_as_float(__builtin_amdgcn_ds_swizzle(__float_as_int(v), (2 << 10) | 0x1f));
  v += __int_as_float(__builtin_amdgcn_ds_swizzle(__float_as_int(v), (4 << 10) | 0x1f));
  v += __int_as_float(__builtin_amdgcn_ds_swizzle(__float_as_int(v), (8 << 10) | 0x1f));
  v += __int_as_float(__builtin_amdgcn_ds_swizzle(__float_as_int(v), (16 << 10) | 0x1f));
  auto rr = __builtin_amdgcn_permlane32_swap(__float_as_uint(v), __float_as_uint(v), false, false);
  return __uint_as_float(rr[0]) + __uint_as_float(rr[1]);
}
DI u32x4 pack8(f32x4 a, f32x4 b) { u32x4 w; w.x = cvtpk(a.x, a.y); w.y = cvtpk(a.z, a.w); w.z = cvtpk(b.x, b.y); w.w = cvtpk(b.z, b.w); return w; }


DI void sincos_cw(float x, float& sn, float& cs) {
  const float k = rintf(x * 0.63661977236758134f);
  float r = fmaf(-k, 1.5703125f, x); r = fmaf(-k, 4.837512969970703125e-4f, r); r = fmaf(-k, 7.54978995489188216e-8f, r);
  const float z = r * r;
  const float sp = fmaf(r * z, fmaf(z, fmaf(z, -1.9515295891e-4f, 8.3321608736e-3f), -1.6666654611e-1f), r);
  const float cp = fmaf(z * z, fmaf(z, fmaf(z, 2.443315711809948e-5f, -1.388731625493765e-3f), 4.166664568298827e-2f), fmaf(z, -0.5f, 1.0f));
  const int q = ((int)k) & 3;
  const float s1 = (q & 1) ? cp : sp, c1 = (q & 1) ? sp : cp;
  sn = (q & 2) ? -s1 : s1; cs = ((q + 1) & 2) ? -c1 : c1;
}
enum { EM_BF16 = 0, EM_QKV = 1, EM_RELU2 = 2, EM_F32 = 3, EM_QROPE = 4, EM_SPLIT = 5, EM_TAIL = 6 };
struct EpiMode {
  static constexpr bool PERM = true, AFTER_DRAIN = false;
  int mode; bf16* O; int ldc; float* F; float* outp;
  bf16* O2;
  const float* rs;
  unsigned char* ws;
  template <int MODE> DI void store8(int row, int col, f32x4 v0, f32x4 v1, int part) const {
    if (MODE == EM_QKV || MODE == EM_RELU2 || MODE == EM_F32) { const float r_ = rs[row]; v0 *= r_; v1 *= r_; }
    if (MODE == EM_TAIL) {
      if (part >= 16) *(u32x4*)(O2 + ((size_t)(part - 16) * 1024 + (row - NPR)) * 2048 + col) = pack8(v0, v1);
      else *(u32x4*)(O + (size_t)row * ldc + col) = pack8(v0, v1);
    } else if (MODE == EM_SPLIT) {
      bf16* d = (part & 1) ? O2 : O; *(u32x4*)(d + (size_t)row * ldc + col) = pack8(v0, v1);
      if (part & 2) *(u32x4*)(O2 + (size_t)row * ldc + col) = (u32x4){0u, 0u, 0u, 0u};
    } else if (MODE == EM_BF16) { *(u32x4*)(O + (size_t)row * ldc + col) = pack8(v0, v1); }
    else if (MODE == EM_RELU2) {
      f32x4 a = __builtin_elementwise_max(v0, (f32x4){0.f, 0.f, 0.f, 0.f}), b = __builtin_elementwise_max(v1, (f32x4){0.f, 0.f, 0.f, 0.f});
      *(u32x4*)(O + (size_t)row * ldc + col) = pack8(a * a, b * b); }
    else if (MODE == EM_F32) { if (col < 1088) *(u32x4*)((bf16*)F + (size_t)row * ldc + col) = pack8(v0, v1); }
    else if (MODE == EM_QKV) {
      const u32x4 w = pack8(v0, v1);
      if (col < 2048) { *(u32x4*)((bf16*)(ws + A_Q0) + (size_t)row * 2048 + col) = w; }
      else {
        const int isv = col >= 4096; const int c = col - (isv ? 4096 : 2048);
        if (row < NPR) {
          *(u32x4*)((bf16*)(ws + (isv ? A_VP : A_KP)) + (size_t)row * 2048 + c) = w;
          const int s = row & 4095, b = row >> 12;
          if (s >= 3584) { float* p = outp + (isv ? O_AVP : O_AKP) + ((size_t)(b * 512 + s - 3584)) * 2048 + c; *(f32x4*)p = v0; *(f32x4*)(p + 4) = v1; }
        } else {
          const int rs = row - NPR, b = rs >> 6, i = rs & 63;
          *(u32x4*)((bf16*)(ws + (isv ? A_VS : A_KS)) + ((size_t)(b * 576 + 512 + i)) * 2048 + c) = w;
          float* p = outp + (isv ? O_AVS : O_AKS) + (size_t)rs * 2048 + c; *(f32x4*)p = v0; *(f32x4*)(p + 4) = v1;
        }
      }
    } else if (MODE == EM_QROPE) {
      if (col >= 2048) {
        const int j = col - 2048, i0 = (j & 63) >> 1;
        const float pos = (float)(row < NPR ? (row & 4095) : PAST + ((row - NPR) & 63));
        float x[8] = {v0.x, v0.y, v0.z, v0.w, v1.x, v1.y, v1.z, v1.w};
#pragma unroll
        for (int p = 0; p < 4; ++p) {
          const float inv = exp2f(-(float)(i0 + p) * 0.41524101186092029f);
          float sn, cs; sincos_cw(pos * inv, sn, cs);
          const float a = x[2 * p], b = x[2 * p + 1];
          x[2 * p] = a * cs - b * sn; x[2 * p + 1] = b * cs + a * sn;
        }
        v0 = (f32x4){x[0], x[1], x[2], x[3]}; v1 = (f32x4){x[4], x[5], x[6], x[7]};
      }
      *(u32x4*)(O + (size_t)row * ldc + col) = pack8(v0, v1);
    }
  }
  template <int MODE> DI void run(const f32x4 (&acc)[2][2][4][2], const pg8::Unit& u, int wr, int wc, int fr, int fq) const {
#pragma unroll
    for (int ai = 0; ai < 2; ++ai)
#pragma unroll
      for (int m = 0; m < 4; ++m) {
        const int row = u.pm * 256 + ai * 128 + wr * 64 + m * 16 + fr;
#pragma unroll
        for (int bj = 0; bj < 2; ++bj) { store8<MODE>(row, u.pn * 256 + bj * 128 + wc * 32 + 8 * fq, acc[ai][bj][m][0], acc[ai][bj][m][1], u.part);
          if (MODE == EM_QROPE || MODE == EM_QKV) asm volatile("" ::: "memory"); }
      }
  }
  DI void operator()(const f32x4 (&acc)[2][2][4][2], const pg8::Unit& u, int wr, int wc, int fr, int fq) const {
    { int t_ = threadIdx.x; asm volatile("" : "+v"(t_)); fr = t_ & 15; fq = (t_ >> 4) & 3; }
    switch (mode) {
      case EM_BF16: run<EM_BF16>(acc, u, wr, wc, fr, fq); break;
      case EM_RELU2: run<EM_RELU2>(acc, u, wr, wc, fr, fq); break;
      case EM_F32: run<EM_F32>(acc, u, wr, wc, fr, fq); break;
      case EM_QKV: run<EM_QKV>(acc, u, wr, wc, fr, fq); break;
      case EM_SPLIT: run<EM_SPLIT>(acc, u, wr, wc, fr, fq); break;
      case EM_TAIL: run<EM_TAIL>(acc, u, wr, wc, fr, fq); break;
      default: run<EM_QROPE>(acc, u, wr, wc, fr, fq); break;
    }
  }
};
DI void run_gemm(LAS unsigned char* lds, const bf16* A, int lda, const bf16* Bt, int M, int N, int K, const EpiMode& E) {
  pg8::Gemm g{A, Bt, M, N, K, lda}; pg8::StaticOrder S; S.init(M, N, K, (int)gridDim.x, (int)blockIdx.x, E.mode == EM_TAIL ? 8 : E.mode == EM_SPLIT ? 2 : 1);
  pg8::gemm_phase<EpiMode, pg8::StaticOrder, true, true>(lds, g, S, E);
}
DI void row_x_prep(const float* xrow, bf16* xbrow, float* rstd_out, int lane) {
  const f32x4* xr = (const f32x4*)xrow + lane;
  f32x4 v[8]; float s = 0.f;
#pragma unroll
  for (int j = 0; j < 8; ++j) { v[j] = xr[64 * j]; s += (v[j].x * v[j].x + v[j].y * v[j].y) + (v[j].z * v[j].z + v[j].w * v[j].w); }
  const float rstd = rsqrtf(wave_sum(s) * (1.f / DM) + EPS);
  u32x2* x8 = (u32x2*)xbrow + lane;
#pragma unroll
  for (int j = 0; j < 8; ++j) { u32x2 w; w.x = cvtpk(v[j].x, v[j].y); w.y = cvtpk(v[j].z, v[j].w); x8[64 * j] = w; }
  if (lane == 0) *rstd_out = rstd;
}
template <bool XINB, bool XOUTB> DI void row_resid_norm(const bf16* trow, const bf16* trow2, int npart, const void* xin, void* xout, const float* gpost, float* rstd_out, int lane) {
  const u32x2* tr = (const u32x2*)trow + lane; const u32x2* tr2 = (const u32x2*)trow2 + lane; const f32x4* gr = (const f32x4*)gpost + lane;
  f32x4 t[8], x[8]; float s = 0.f;
#pragma unroll
  for (int j = 0; j < 8; ++j) {
    if (npart == 8) { f32x4 acc4 = {0.f, 0.f, 0.f, 0.f};
#pragma unroll
      for (int p = 0; p < 8; ++p) { const u32x2 w = (tr2 + (size_t)p * (1024 * 2048 / 4))[64 * j]; acc4 += (f32x4){bflo(w.x), bfhi(w.x), bflo(w.y), bfhi(w.y)}; }
      t[j] = acc4;
    } else { const u32x2 w = tr[64 * j]; u32x2 w2 = {0u, 0u}; if (npart == 1) w2 = tr2[64 * j]; t[j] = (f32x4){bflo(w.x) + bflo(w2.x), bfhi(w.x) + bfhi(w2.x), bflo(w.y) + bflo(w2.y), bfhi(w.y) + bfhi(w2.y)}; }
    s += (t[j].x * t[j].x + t[j].y * t[j].y) + (t[j].z * t[j].z + t[j].w * t[j].w); }
#pragma unroll
  for (int j = 0; j < 8; ++j) { if (XINB) { const u32x2 w = ((const u32x2*)xin + lane)[64 * j]; x[j] = (f32x4){bflo(w.x), bfhi(w.x), bflo(w.y), bfhi(w.y)}; } else x[j] = ((const f32x4*)xin + lane)[64 * j]; }
  const float rstd = rsqrtf(wave_sum(s) * (1.f / DM) + EPS);
  float s2 = 0.f;
#pragma unroll
  for (int j = 0; j < 8; ++j) { const f32x4 gg = gr[64 * j]; x[j] = x[j] + t[j] * rstd * gg; s2 += (x[j].x * x[j].x + x[j].y * x[j].y) + (x[j].z * x[j].z + x[j].w * x[j].w); }
  asm volatile("s_waitcnt vmcnt(0)" ::: "memory");
#pragma unroll
  for (int j = 0; j < 8; ++j) { if (XOUTB) { u32x2 w; w.x = cvtpk(x[j].x, x[j].y); w.y = cvtpk(x[j].z, x[j].w); ((u32x2*)xout + lane)[64 * j] = w; } else ((f32x4*)xout + lane)[64 * j] = x[j]; }
  if (rstd_out) { const float rstd2 = rsqrtf(wave_sum(s2) * (1.f / DM) + EPS); if (lane == 0) *rstd_out = rstd2; }
}
DI bf16* xb_row(float* outp, int m) { return (bf16*)((char*)outp + (size_t)m * 8192 + 4096); }
DI void row_mla(const bf16* d, int row, const float* qn, const float* kvn, unsigned char* ws, float* outp, int lane) {
  f32x4 a[2], c[2]; float sa = 0.f, sc = 0.f;
#pragma unroll
  for (int j = 0; j < 2; ++j) { const u32x2 wa = *(const u32x2*)(d + 4 * lane + 256 * j), wc = *(const u32x2*)(d + 512 + 4 * lane + 256 * j);
    a[j] = (f32x4){bflo(wa.x), bfhi(wa.x), bflo(wa.y), bfhi(wa.y)}; c[j] = (f32x4){bflo(wc.x), bfhi(wc.x), bflo(wc.y), bfhi(wc.y)};
    sa += (a[j].x * a[j].x + a[j].y * a[j].y) + (a[j].z * a[j].z + a[j].w * a[j].w); sc += (c[j].x * c[j].x + c[j].y * c[j].y) + (c[j].z * c[j].z + c[j].w * c[j].w); }
  const float ra = rsqrtf(wave_sum(sa) * (1.f / 512.f) + EPS), rc = rsqrtf(wave_sum(sc) * (1.f / 512.f) + EPS);
  bf16* cq = (bf16*)(ws + A_CQ) + (size_t)row * 512;
  bf16* ckv; bf16* kr; float* fckv; float* fkr;
  if (row < NPR) { ckv = (bf16*)(ws + A_CKVP) + (size_t)row * 512; kr = (bf16*)(ws + A_KRP) + (size_t)row * 64; fckv = outp + O_CKVP + (size_t)row * 512; fkr = outp + O_KRP + (size_t)row * 64; }
  else { const int rs = row - NPR, b = rs >> 6, i = rs & 63; const size_t r2 = (size_t)b * 2112 + 2048 + i;
    ckv = (bf16*)(ws + A_CKVS) + r2 * 512; kr = (bf16*)(ws + A_KRS) + r2 * 64; fckv = outp + O_CKVS + (size_t)rs * 512; fkr = outp + O_KRS + (size_t)rs * 64; }
#pragma unroll
  for (int j = 0; j < 2; ++j) {
    const f32x4 g1 = *(const f32x4*)(qn + 4 * lane + 256 * j), g2 = *(const f32x4*)(kvn + 4 * lane + 256 * j);
    const f32x4 q = a[j] * ra * g1, k = c[j] * rc * g2;
    u32x2 w; w.x = cvtpk(q.x, q.y); w.y = cvtpk(q.z, q.w); *(u32x2*)(cq + 4 * lane + 256 * j) = w;
    w.x = cvtpk(k.x, k.y); w.y = cvtpk(k.z, k.w); *(u32x2*)(ckv + 4 * lane + 256 * j) = w;
    *(f32x4*)(fckv + 4 * lane + 256 * j) = k;
  }
  if (lane < 32) {
    const float x1 = __uint_as_float((unsigned)d[1024 + lane] << 16), x2 = __uint_as_float((unsigned)d[1056 + lane] << 16);
    const float pos = (float)(row < NPR ? (row & 4095) : PAST + ((row - NPR) & 63));
    const float inv = exp2f(-(float)lane * 0.41524101186092029f);
    float sn, cs; sincos_cw(pos * inv, sn, cs);
    const float o1 = x1 * cs - x2 * sn, o2 = x2 * cs + x1 * sn;
    fkr[lane] = o1; fkr[32 + lane] = o2;
    *(unsigned*)(kr + 2 * lane) = cvtpk(o1, o2);
  }
}

DI unsigned f2bf(float f) { unsigned u = __builtin_bit_cast(unsigned, f); return (u + 0x7fffu + ((u >> 16) & 1u)) >> 16; }
DI unsigned pk2(float lo, float hi) { return f2bf(lo) | (f2bf(hi) << 16); }
template <int RMAP> DI void transpose_item(const float* W, int K, int N, bf16* WT, int row_off, LAS float* scr, int item, int lane, const float* gk = nullptr) {
  const int nblk = N / 64, kb = item / nblk, nb = item % nblk, k0 = 64 * kb, n0 = 64 * nb;
  const int lr = lane >> 4, lc = (lane & 15) * 4;
  f32x4 v[16];
#pragma unroll
  for (int i = 0; i < 16; ++i) v[i] = *(const f32x4*)(W + (size_t)(k0 + 4 * i + lr) * N + n0 + lc);
#pragma unroll
  for (int i = 0; i < 16; ++i) { LAS float* d = scr + (4 * i + lr) * 65 + lc; d[0] = v[i].x; d[1] = v[i].y; d[2] = v[i].z; d[3] = v[i].w; }
  asm volatile("s_waitcnt lgkmcnt(0)" ::: "memory");
  const int c = lane & 7;
  f32x4 ga = {1.f, 1.f, 1.f, 1.f}, gb = ga; if (gk) { ga = *(const f32x4*)(gk + k0 + 8 * c); gb = *(const f32x4*)(gk + k0 + 8 * c + 4); }
#pragma unroll
  for (int j = 0; j < 8; ++j) { const int n = (lane >> 3) + 8 * j; const LAS float* s = scr + (8 * c) * 65 + n;
    u32x4 o; o.x = cvtpk(s[0 * 65] * ga.x, s[1 * 65] * ga.y); o.y = cvtpk(s[2 * 65] * ga.z, s[3 * 65] * ga.w); o.z = cvtpk(s[4 * 65] * gb.x, s[5 * 65] * gb.y); o.w = cvtpk(s[6 * 65] * gb.z, s[7 * 65] * gb.w);
    int orow = row_off + n0 + n;
    if (RMAP == 1) { const int nn = n0 + n, h = nn / 192, e = nn % 192; if (e < 128) orow = h * 128 + e; else { const int jj = e - 128; orow = 2048 + h * 64 + (jj < 32 ? 2 * jj : 2 * (jj - 32) + 1); } }
    *(u32x4*)(WT + (size_t)orow * K + k0 + 8 * c) = o; }
  asm volatile("s_waitcnt lgkmcnt(0)" ::: "memory");
}
namespace att {
constexpr int SHM_V = 16384, SHM_K = 64 * 272, SHM_KR = 64 * 144;
constexpr int OFF_V = 0, OFF_K = 2 * SHM_V, OFF_KR = OFF_K + 2 * SHM_K, OFF_WS = OFF_KR + 2 * SHM_KR, OFF_BIAS = OFF_WS + 8 * 64 * 4, LDS_END = OFF_BIAS + 640 * 4;
#define KSWZ(row, colB) ((row) * 272 + (colB))
#define KRSWZ(row, colB) ((row) * 144 + (colB))
#define SBAR() __builtin_amdgcn_sched_barrier(0)
DI int crow(int r, int hi) { return (r & 3) + 8 * (r >> 2) + 4 * hi; }
struct Unit {
  const bf16* Q; const bf16* Qr; int ldq;
  const bf16* K; const bf16* V; const bf16* KR; int ldk;
  bf16* O; int ldo;
  int nt, nact, thi0, tlo0, qrel0;
  const float* bias;
};
template <bool BAND> DI void partialSM(f32x16& p0, f32x16& p1, float& m_reg, float& mn, float& alpha, bool masked, const LAS float* tb, float C) {
  if (masked) {
#pragma unroll
    for (int r = 0; r < 16; ++r) { p0[r] = -1e30f; p1[r] = -1e30f; }
  } else if (BAND) {
#pragma unroll
    for (int r = 0; r < 16; ++r) { const int ko = (r & 3) + 8 * (r >> 2); p0[r] = fmaf(p0[r], C, tb[ko]); }
    SBAR();
#pragma unroll
    for (int r = 0; r < 16; ++r) { const int ko = (r & 3) + 8 * (r >> 2); p1[r] = fmaf(p1[r], C, tb[ko + 32]); }
  }
  const float CC = BAND ? 1.f : C;
  const float THRP = 11.5f / CC;
  float pmax = p0[0];
#pragma unroll
  for (int r = 1; r < 16; ++r) pmax = fmaxf(pmax, p0[r]);
#pragma unroll
  for (int r = 0; r < 16; ++r) pmax = fmaxf(pmax, p1[r]);
  { auto rr = __builtin_amdgcn_permlane32_swap(__float_as_uint(pmax), __float_as_uint(pmax), false, false);
    pmax = fmaxf(__uint_as_float(rr[0]), __uint_as_float(rr[1])); }
  if (__builtin_expect(__all(pmax - m_reg <= THRP), 1)) { mn = m_reg; alpha = 1.f; }
  else { mn = fmaxf(m_reg, pmax); alpha = __builtin_amdgcn_exp2f((m_reg - mn) * CC); m_reg = mn; }
  const float mnC = -mn * CC;
#pragma unroll
  for (int r = 0; r < 16; ++r) p0[r] = fmaf(p0[r], CC, mnC);
#pragma unroll
  for (int r = 0; r < 16; ++r) p1[r] = fmaf(p1[r], CC, mnC);
#pragma unroll
  for (int r = 0; r < 16; ++r) p0[r] = __builtin_amdgcn_exp2f(p0[r]);
}
DI void finishSM(f32x16& p0, f32x16& p1, float alpha, float& l_reg, bf16x8& pa0, bf16x8& pa1, bf16x8& pa2, bf16x8& pa3) {
#pragma unroll
  for (int r = 0; r < 16; ++r) p1[r] = __builtin_amdgcn_exp2f(p1[r]);
  float ps = 0;
#pragma unroll
  for (int r = 0; r < 16; ++r) ps += p0[r];
#pragma unroll
  for (int r = 0; r < 16; ++r) ps += p1[r];
  { auto rr = __builtin_amdgcn_permlane32_swap(__float_as_uint(ps), __float_as_uint(ps), false, false);
    ps = __uint_as_float(rr[0]) + __uint_as_float(rr[1]); }
  l_reg = l_reg * alpha + ps;
#define PK4(P, BASE, OUT) do { unsigned a0 = cvtpk(P[BASE + 0], P[BASE + 1]), a1 = cvtpk(P[BASE + 2], P[BASE + 3]);   \
    unsigned b0 = cvtpk(P[BASE + 4], P[BASE + 5]), b1 = cvtpk(P[BASE + 6], P[BASE + 7]);                              \
    auto r0 = __builtin_amdgcn_permlane32_swap(a0, b0, false, false); auto r1 = __builtin_amdgcn_permlane32_swap(a1, b1, false, false); \
    u32x4 w = {r0[0], r1[0], r0[1], r1[1]}; OUT = __builtin_bit_cast(bf16x8, w); } while (0)
  PK4(p0, 0, pa0); PK4(p0, 8, pa1); PK4(p1, 0, pa2); PK4(p1, 8, pa3);
#undef PK4
}
template <int NQ> DI void qkt(f32x16& p0, f32x16& p1, const LAS char* Ks, const LAS char* KRs, const bf16x8* qr, int r32, int hi) {
  p0 = f32x16{}; p1 = f32x16{};
#pragma unroll
  for (int d0 = 0; d0 < 8; ++d0) { const int cb = (d0 * 16 + hi * 8) * 2;
    const bf16x8 b0 = *(const LAS bf16x8*)(Ks + KSWZ(r32, cb));
    const bf16x8 b1 = *(const LAS bf16x8*)(Ks + KSWZ(32 + r32, cb));
    p0 = __builtin_amdgcn_mfma_f32_32x32x16_bf16(b0, qr[d0], p0, 0, 0, 0);
    p1 = __builtin_amdgcn_mfma_f32_32x32x16_bf16(b1, qr[d0], p1, 0, 0, 0); }
  if (NQ == 12) {
#pragma unroll
    for (int d0 = 0; d0 < 4; ++d0) { const int cb = (d0 * 16 + hi * 8) * 2;
      const bf16x8 b0 = *(const LAS bf16x8*)(KRs + KRSWZ(r32, cb));
      const bf16x8 b1 = *(const LAS bf16x8*)(KRs + KRSWZ(32 + r32, cb));
      p0 = __builtin_amdgcn_mfma_f32_32x32x16_bf16(b0, qr[8 + d0], p0, 0, 0, 0);
      p1 = __builtin_amdgcn_mfma_f32_32x32x16_bf16(b1, qr[8 + d0], p1, 0, 0, 0); }
  }
}
DI int v_st(int k, int c) { const int kk = (k & ~0xC) | ((k & 4) << 1) | ((k & 8) >> 1); return ((kk >> 3) * 4 + (c >> 5)) * 512 + ((kk & 7) * 32 + (c & 31)) * 2; }
DI int v_rd_base(int lane) { return ((lane & 3) << 3) | (((lane >> 2) & 3) << 6) | (((lane >> 4) & 1) << 5) | (((lane >> 5) & 1) << 8); }
constexpr int v_rd_off(int d0, int ks, int half) { return d0 * 512 + ks * 4096 + half * 2048; }
template <int OFF> DI s16x4 tr_read(int vb) { s16x4 r; asm volatile("ds_read_b64_tr_b16 %0, %1 offset:%2" : "=&v"(r) : "v"(vb), "i"(OFF) : "memory"); return r; }
template <int D0> DI void pv_one(f32x16& od, int vb, bf16x8 pa0, bf16x8 pa1, bf16x8 pa2, bf16x8 pa3) {
  const s16x4 l0 = tr_read<v_rd_off(D0, 0, 0)>(vb), h0 = tr_read<v_rd_off(D0, 0, 1)>(vb), l1 = tr_read<v_rd_off(D0, 1, 0)>(vb), h1 = tr_read<v_rd_off(D0, 1, 1)>(vb);
  const s16x4 l2 = tr_read<v_rd_off(D0, 2, 0)>(vb), h2 = tr_read<v_rd_off(D0, 2, 1)>(vb), l3 = tr_read<v_rd_off(D0, 3, 0)>(vb), h3 = tr_read<v_rd_off(D0, 3, 1)>(vb);
  asm volatile("s_waitcnt lgkmcnt(0)" ::: "memory"); SBAR();
#define PK(L, H) (bf16x8){L[0], L[1], L[2], L[3], H[0], H[1], H[2], H[3]}
  od = __builtin_amdgcn_mfma_f32_32x32x16_bf16(pa0, PK(l0, h0), od, 0, 0, 0);
  od = __builtin_amdgcn_mfma_f32_32x32x16_bf16(pa1, PK(l1, h1), od, 0, 0, 0);
  od = __builtin_amdgcn_mfma_f32_32x32x16_bf16(pa2, PK(l2, h2), od, 0, 0, 0);
  od = __builtin_amdgcn_mfma_f32_32x32x16_bf16(pa3, PK(l3, h3), od, 0, 0, 0);
#undef PK
}
DI void pv_d0(f32x16* o, int vb, bf16x8 pa0, bf16x8 pa1, bf16x8 pa2, bf16x8 pa3) {
  pv_one<0>(o[0], vb, pa0, pa1, pa2, pa3); pv_one<1>(o[1], vb, pa0, pa1, pa2, pa3); pv_one<2>(o[2], vb, pa0, pa1, pa2, pa3); pv_one<3>(o[3], vb, pa0, pa1, pa2, pa3);
}

template <bool BAND, int SD, bool ACT> DI void attn_unit_(const Unit& U, LAS char* lds, float C) {
  constexpr int NQ = BAND ? 8 : 12;
  int tid = threadIdx.x; asm volatile("" : "+v"(tid)); const int wid = __builtin_amdgcn_readfirstlane(tid >> 6), lane = tid & 63, r32 = lane & 31, hi = lane >> 5;
  LAS char* V_lds = lds + OFF_V; LAS char* K_lds = lds + OFF_K; LAS char* KR_lds = lds + OFF_KR;
  LAS float* wsf = (LAS float*)(lds + OFF_WS) + wid * 64; LAS float* li_l = wsf; LAS float* al_l = wsf + 32;
  LAS float* T3 = (LAS float*)(lds + OFF_BIAS);
  const int wq = wid & (U.nact - 1);
  const int cw = wid >> 1; const int t_hi = U.thi0 + cw; const int t_lo = (U.tlo0 + cw) > 0 ? (U.tlo0 + cw) : 0;
  float m_reg = -1e30f, l_reg = 0; f32x16 o[4] = {}; bf16x8 qr[NQ];
  if (ACT) {
    const bf16* Qw = U.Q + (size_t)(wq * 32 + r32) * U.ldq + hi * 8;
#pragma unroll
    for (int d0 = 0; d0 < 8; ++d0) qr[d0] = *(const bf16x8*)(Qw + d0 * 16);
    if (!BAND) { const bf16* Qw2 = U.Qr + (size_t)(wq * 32 + r32) * U.ldq + hi * 8;
#pragma unroll
      for (int d0 = 0; d0 < 4; ++d0) qr[(NQ == 12 ? 8 : 0) + d0] = *(const bf16x8*)(Qw2 + d0 * 16); }
  }
  if (BAND) { for (int j = tid; j < 640; j += 512) { int rel = 575 - j; rel = rel > 256 ? 256 : rel; T3[j] = U.bias[rel + 256] * LOG2E; } }
  const int sr = tid >> 4, sc = (tid & 15) * 8, vst0 = v_st(sr, sc), vst1 = v_st(32 + sr, sc);
  const int krr = tid >> 3, krc = (tid & 7) * 8;
  const int vb0 = (int)(uintptr_t)V_lds + v_rd_base(lane);
  const int jb0 = 575 - U.qrel0 - 32 * wq - r32 + 4 * hi;
  struct { bf16x8 vs0, vs1, ks0, ks1, kr; } sr_[SD];
  const int ntr = U.nt, NT = (U.nt + 1) & ~1;
  const unsigned vo0 = (unsigned)(sr * U.ldk + sc) * 2u, vo1 = (unsigned)((32 + sr) * U.ldk + sc) * 2u, vokr = (unsigned)(krr * 64 + krc) * 2u;
  const size_t tstep = (size_t)64 * U.ldk * 2;
#define SLOAD(i, t) do { const int tt_ = (t) < ntr ? (t) : ntr - 1; const char* kt_ = (const char*)U.K + tt_ * tstep; const char* vt_ = (const char*)U.V + tt_ * tstep;  \
    sr_[i].vs0 = *(const bf16x8*)(vt_ + vo0); sr_[i].vs1 = *(const bf16x8*)(vt_ + vo1);         \
    sr_[i].ks0 = *(const bf16x8*)(kt_ + vo0); sr_[i].ks1 = *(const bf16x8*)(kt_ + vo1);         \
    if (!BAND) sr_[i].kr = *(const bf16x8*)((const char*)U.KR + (size_t)tt_ * 8192 + vokr); } while (0)
#define SWRITE(b, i) do { *(LAS bf16x8*)(V_lds + (b) * SHM_V + vst0) = sr_[i].vs0; *(LAS bf16x8*)(V_lds + (b) * SHM_V + vst1) = sr_[i].vs1; \
    const int kc_ = sc * 2; *(LAS bf16x8*)(K_lds + (b) * SHM_K + KSWZ(sr, kc_)) = sr_[i].ks0; *(LAS bf16x8*)(K_lds + (b) * SHM_K + KSWZ(32 + sr, kc_)) = sr_[i].ks1; \
    if (!BAND) *(LAS bf16x8*)(KR_lds + (b) * SHM_KR + KRSWZ(krr, krc * 2)) = sr_[i].kr; } while (0)
#define SWAIT() do { if (SD == 2) asm volatile("s_waitcnt vmcnt(%0)" ::"n"(BAND ? 4 : 5) : "memory"); else asm volatile("s_waitcnt vmcnt(0)" ::: "memory"); } while (0)
#define RESC(a) do { if (__any((a) < 1.f)) { if (hi == 0) al_l[r32] = (a); asm volatile("s_waitcnt lgkmcnt(0)" ::: "memory"); \
    _Pragma("unroll") for (int d = 0; d < 4; ++d) _Pragma("unroll") for (int r = 0; r < 16; ++r) o[d][r] *= al_l[crow(r, hi)]; } } while (0)
#define MASKED(t) ((t) < t_lo || (t) > t_hi)
  f32x16 pA0, pA1, pB0, pB1; float mnA, mnB, alA = 1.f, alB = 1.f; bf16x8 pa0, pa1, pa2, pa3;
  { u32x4 zz = {0u, 0u, 0u, 0u}; asm volatile("" : "+v"(zz)); pa0 = pa1 = pa2 = pa3 = __builtin_bit_cast(bf16x8, zz); }
  constexpr int SE = 0, SO = SD - 1;
  SLOAD(SE, 0); if (SD == 2) SLOAD(SO, 1);
  if (SD == 2) asm volatile("s_waitcnt vmcnt(%0)" ::"n"(BAND ? 4 : 5) : "memory"); else asm volatile("s_waitcnt vmcnt(0)" ::: "memory");
  SWRITE(0, SE);
  if (SD == 2) { if (2 < NT) SLOAD(SE, 2); } else SLOAD(SO, 1);
  __syncthreads();
  if (ACT) { qkt<NQ>(pA0, pA1, K_lds, KR_lds, qr, r32, hi); partialSM<BAND>(pA0, pA1, m_reg, mnA, alA, MASKED(0), T3 + jb0, C); }
  SWAIT(); SWRITE(1, SO); __syncthreads();
  for (int j = 1; j + 1 < NT; j += 2) {
    SBAR();
    if (ACT) { qkt<NQ>(pB0, pB1, K_lds + SHM_K, KR_lds + SHM_KR, qr, r32, hi); finishSM(pA0, pA1, alA, l_reg, pa0, pa1, pa2, pa3); }
    SBAR();
    SLOAD(SO, j + SD); SBAR();
    if (ACT) { pv_d0(o, vb0, pa0, pa1, pa2, pa3); partialSM<BAND>(pB0, pB1, m_reg, mnB, alB, MASKED(j), T3 + jb0 + 64 * j, C); }
    __syncthreads(); SWAIT(); SWRITE(0, SE);
    if (ACT) RESC(alB);
    __syncthreads();
    SBAR();
    if (ACT) { qkt<NQ>(pA0, pA1, K_lds, KR_lds, qr, r32, hi); finishSM(pB0, pB1, alB, l_reg, pa0, pa1, pa2, pa3); }
    SBAR();
    if (SD == 1 || j + 3 < NT) SLOAD(SE, j + 1 + SD); SBAR();
    if (ACT) { pv_d0(o, vb0 + SHM_V, pa0, pa1, pa2, pa3); partialSM<BAND>(pA0, pA1, m_reg, mnA, alA, MASKED(j + 1), T3 + jb0 + 64 * (j + 1), C); }
    __syncthreads(); SWAIT(); SWRITE(1, SO);
    if (ACT) RESC(alA);
    __syncthreads();
  }
  SBAR();
  if (ACT) {
    qkt<NQ>(pB0, pB1, K_lds + SHM_K, KR_lds + SHM_KR, qr, r32, hi);
    finishSM(pA0, pA1, alA, l_reg, pa0, pa1, pa2, pa3); SBAR();
    pv_d0(o, vb0, pa0, pa1, pa2, pa3); partialSM<BAND>(pB0, pB1, m_reg, mnB, alB, MASKED(NT - 1), T3 + jb0 + 64 * (NT - 1), C);
  }
  __syncthreads();
  if (ACT) {
    RESC(alB);
    finishSM(pB0, pB1, alB, l_reg, pa0, pa1, pa2, pa3); SBAR();
    pv_d0(o, vb0 + SHM_V, pa0, pa1, pa2, pa3);
    if (hi == 0) li_l[r32] = l_reg; asm volatile("s_waitcnt lgkmcnt(0)" ::: "memory");
    float rli[16];
#pragma unroll
    for (int r = 0; r < 16; ++r) rli[r] = __builtin_amdgcn_rcpf(li_l[crow(r, hi)]);
    LAS char* stg = lds + (wid < 2 ? OFF_V + wid * 8192 : OFF_K + (wid - 2) * 8192);
#pragma unroll
    for (int r = 0; r < 16; ++r) { const int orow = crow(r, hi);
#pragma unroll
      for (int d0 = 0; d0 < 4; ++d0) *(LAS bf16*)(stg + orow * 256 + (d0 * 32 + r32) * 2) = (bf16)(cvtpk(o[d0][r] * rli[r], 0.f) & 0xffffu); }
    asm volatile("s_waitcnt lgkmcnt(0)" ::: "memory");
    bf16* Ow = U.O + (size_t)(wid * 32) * U.ldo;
#pragma unroll
    for (int i = 0; i < 8; ++i) { const int row = i * 4 + (lane >> 4), ch = lane & 15; const u32x4 v = *(const LAS u32x4*)(stg + row * 256 + ch * 16); *(u32x4*)(Ow + (size_t)row * U.ldo + ch * 8) = v; }
  }
  asm volatile("s_waitcnt vmcnt(0) lgkmcnt(0)" ::: "memory");
  __syncthreads();
#undef SLOAD
#undef SWRITE
#undef SWAIT
#undef RESC
#undef MASKED
}
template <bool BAND, int SD> DI void attn_unit(const Unit& U, LAS char* lds, float C) {
  const int wid = __builtin_amdgcn_readfirstlane((int)threadIdx.x >> 6);
  if (wid < U.nact) attn_unit_<BAND, SD, true>(U, lds, C); else attn_unit_<BAND, SD, false>(U, lds, C);
}
}
#define XB_TMO      128
#define XB_XCNT(j)  (256  + 64 * (j))
#define XB_XSUB(j)  (1280 + 64 * (j))
#define XB_XGEN(j)  (2304 + 64 * (j))
#define XB_TOP      3328
#define XB_TOPGEN   3392
#define XCD_BAR_WORDS 3456
#define XB_SPIN_CAP (1u << 18)

__device__ __forceinline__ unsigned xb_ld(unsigned* p)              { return __hip_atomic_load(p, __ATOMIC_RELAXED, __HIP_MEMORY_SCOPE_AGENT); }
__device__ __forceinline__ unsigned xb_add(unsigned* p, unsigned v) { return __hip_atomic_fetch_add(p, v, __ATOMIC_RELAXED, __HIP_MEMORY_SCOPE_AGENT); }
__device__ __forceinline__ unsigned xb_xcc_id() { return (unsigned)__builtin_amdgcn_s_getreg((3 << 11) | 20) & 0xFu; }
#define XB_SPIN(cond, bar) do { unsigned _sp = 0; while (cond) { __builtin_amdgcn_s_sleep(1); \
    if ((++_sp & 255u) == 0u) { if (xb_ld(&(bar)[XB_TMO])) break; if (_sp > XB_SPIN_CAP) { atomicAdd(&(bar)[XB_TMO], 1u); break; } } } } while (0)

struct XcdBarrier {
    unsigned* bar; unsigned x;
    volatile LAS unsigned* st;
};

__device__ __forceinline__ XcdBarrier xcd_barrier_post(unsigned* bar, volatile LAS unsigned* st) {
    XcdBarrier b; b.bar = bar; b.x = xb_xcc_id(); b.st = st;
    if (threadIdx.x == 0) (void)xb_add(&bar[XB_XCNT(b.x)], 1u);
    return b;
}
__device__ __forceinline__ void xcd_barrier_complete(unsigned* bar, unsigned x, unsigned& nloc, unsigned& nx) {
    const unsigned G = gridDim.x * gridDim.y * gridDim.z;
    unsigned sum, cnt, mine, sp = 0u;
    for (;;) {
        sum = 0u; cnt = 0u; mine = 0u;
#pragma unroll
        for (unsigned j = 0; j < 16; ++j) { const unsigned c = xb_ld(&bar[XB_XCNT(j)]); sum += c; cnt += (c > 0u) ? 1u : 0u; mine = (j == x) ? c : mine; }
        if (sum == G) break;
        __builtin_amdgcn_s_sleep(1);
        if ((++sp & 255u) == 0u) { if (xb_ld(&bar[XB_TMO])) break; if (sp > XB_SPIN_CAP) { atomicAdd(&bar[XB_TMO], 1u); break; } }
    }
    nloc = mine > 0u ? mine : 1u; nx = cnt > 0u ? cnt : 1u;
}

__device__ __forceinline__ void xcd_barrier(const XcdBarrier& b) {
    asm volatile("s_waitcnt vmcnt(0)" ::: "memory");
    __syncthreads();
    if (threadIdx.x == 0) {
        unsigned* bar = b.bar;
        __builtin_amdgcn_s_waitcnt(0);
        unsigned nloc = b.st[0], nx = b.st[1];
        if (nloc == 0u) { xcd_barrier_complete(bar, b.x, nloc, nx); b.st[0] = nloc; b.st[1] = nx; }
        const unsigned old = xb_add(&bar[XB_XSUB(b.x)], 1u);
        const unsigned gen = old / nloc;
        if (old + 1u == (gen + 1u) * nloc) {
            __builtin_amdgcn_fence(__ATOMIC_RELEASE, "agent");
            asm volatile("s_waitcnt vmcnt(0)" ::: "memory");
            const unsigned og = xb_add(&bar[XB_TOP], 1u);
            const unsigned tg = og / nx;
            if (og + 1u == (tg + 1u) * nx) xb_add(&bar[XB_TOPGEN], 1u);
            else XB_SPIN(xb_ld(&bar[XB_TOPGEN]) == tg, bar);
            __builtin_amdgcn_fence(__ATOMIC_ACQUIRE, "agent");
            xb_add(&bar[XB_XGEN(b.x)], 1u);
            asm volatile("s_waitcnt vmcnt(0)" ::: "memory");
        } else {
            XB_SPIN(xb_ld(&bar[XB_XGEN(b.x)]) == gen, bar);
            __builtin_amdgcn_fence(__ATOMIC_ACQUIRE, "agent");
            asm volatile("s_waitcnt vmcnt(0)" ::: "memory");
        }
    }
    __syncthreads();
}

#ifndef PROBE_PH
#define PROBE_PH 0
#endif
#ifndef PROBE_REP
#define PROBE_REP 0
#endif
#ifndef PROBE_SYNC
#define PROBE_SYNC 0
#endif
#ifndef BAND_SD
#define BAND_SD 2
#endif
#ifndef MLA_SD
#define MLA_SD 1
#endif
constexpr int NSTEPS = 20;
struct Args { const float* in[23]; float* out; unsigned char* ws; int ph_lo, ph_hi; };
constexpr int LDS_BYTES = 133120 + 1024;

typedef const __attribute__((address_space(4))) Args CArgs;
DI const float* xin_row(CArgs& a, int row) { return row < NPR ? a.in[0] + (size_t)row * DM : a.in[1] + (size_t)(row - NPR) * DM; }

DI bool get_gemm(int ph, bool tail8, CArgs& a, const bf16*& A, int& lda, const bf16*& Bt, int& M, int& N, int& K, EpiMode& E) {
  unsigned char* ws = a.ws;
  E.mode = EM_BF16; E.O = nullptr; E.O2 = nullptr; E.ldc = 0; E.F = nullptr; E.outp = a.out; E.ws = ws; E.rs = (const float*)(ws + A_RSTD); lda = 0;
  switch (ph) {
    case 1:  A = (const bf16*)((const char*)a.out + 4096); lda = 4096; Bt = (const bf16*)(ws + W_QKV); M = MT; N = 6144; K = 2048; E.mode = EM_QKV; return true;
    case 3:  A = (const bf16*)(ws + A_O0);   Bt = (const bf16*)(ws + W_AO);  M = MT; N = 2048; K = 2048; E.O = (bf16*)(ws + A_T); E.ldc = 2048; if (tail8) { E.mode = EM_TAIL; E.O2 = (bf16*)(ws + A_Q0); } return true;
    case 5:  A = (const bf16*)((const char*)a.out + 4096); lda = 4096; Bt = (const bf16*)(ws + W_F1);  M = MT; N = 8192; K = 2048; E.mode = EM_RELU2; E.O = (bf16*)(ws + A_HID); E.ldc = 8192; return true;
    case 6:  A = (const bf16*)(ws + A_HID);  Bt = (const bf16*)(ws + W_F2);  M = MT; N = 2048; K = 8192; E.mode = tail8 ? EM_TAIL : EM_SPLIT; E.O = (bf16*)(ws + A_T); E.O2 = (bf16*)(ws + (tail8 ? A_PF : A_H)); E.ldc = 2048; return true;
    case 8:  A = (const bf16*)((const char*)a.out + 4096); lda = 4096; Bt = (const bf16*)(ws + W_D);   M = MT; N = 1280; K = 2048; E.mode = EM_F32; E.F = (float*)(ws + A_DQ); E.ldc = 1280; return true;
    case 10: A = (const bf16*)(ws + A_CQ);   Bt = (const bf16*)(ws + W_UQ);  M = MT; N = 3072; K = 512; E.mode = EM_QROPE; E.O = (bf16*)(ws + A_QM); E.ldc = 3072; return true;
    case 11: A = (const bf16*)(ws + A_CKVP); Bt = (const bf16*)(ws + W_UKV); M = NPR; N = 4096; K = 512; E.O = (bf16*)(ws + A_KNV); E.ldc = 4096; return true;
    case 13: A = (const bf16*)(ws + A_CKVS); Bt = (const bf16*)(ws + W_UKV); M = 33792; N = 4096; K = 512; E.O = (bf16*)(ws + A_KNV); E.ldc = 4096; return true;
    case 15: A = (const bf16*)(ws + A_O1);   Bt = (const bf16*)(ws + W_MO);  M = MT; N = 2048; K = 2048; E.O = (bf16*)(ws + A_T); E.ldc = 2048; if (tail8) { E.mode = EM_TAIL; E.O2 = (bf16*)(ws + A_QM); } return true;
    case 17: A = (const bf16*)((const char*)a.out + 4096); lda = 4096; Bt = (const bf16*)(ws + W_F1);  M = MT; N = 8192; K = 2048; E.mode = EM_RELU2; E.O = (bf16*)(ws + A_HID); E.ldc = 8192; return true;
    case 18: A = (const bf16*)(ws + A_HID);  Bt = (const bf16*)(ws + W_F2);  M = MT; N = 2048; K = 8192; E.mode = tail8 ? EM_TAIL : EM_SPLIT; E.O = (bf16*)(ws + A_T); E.O2 = (bf16*)(ws + (tail8 ? A_PF : A_H)); E.ldc = 2048; return true;
    default: return false;
  }
}

__global__ void __launch_bounds__(512) fwd_mega(Args a_) {
  extern __shared__ __attribute__((aligned(16))) unsigned char lds_raw[];
  LAS unsigned char* lds = (LAS unsigned char*)lds_raw;
  cg::grid_group grid = cg::this_grid();
  if (threadIdx.x < 2) ((volatile LAS unsigned*)(lds + 133120))[threadIdx.x] = 0u;
  __syncthreads();
  const XcdBarrier xbar = xcd_barrier_post((unsigned*)(a_.ws + A_BAR), (volatile LAS unsigned*)(lds + 133120));
  for (int it_ = a_.ph_lo; it_ < a_.ph_hi; ++it_) {
    const int ph = it_ <= PROBE_PH ? it_ : (it_ <= PROBE_PH + PROBE_REP ? PROBE_PH : it_ - PROBE_REP);
    const __attribute__((address_space(4))) char* kp_ = (const __attribute__((address_space(4))) char*)__builtin_amdgcn_kernarg_segment_ptr();
    asm volatile("" : "+s"(kp_));
    CArgs& a = *(CArgs*)kp_;
    int tid = threadIdx.x; asm volatile("" : "+v"(tid));
    const int lane = tid & 63, wave = __builtin_amdgcn_readfirstlane(tid >> 6);
    const int G = gridDim.x, gw = blockIdx.x * 8 + wave, NGW = G * 8;
    const size_t gt = (size_t)blockIdx.x * 512 + tid, NGT = (size_t)G * 512;
    unsigned char* ws = a.ws; float* outp = a.out;
    const bf16* gA; const bf16* gB; int gM, gN, gK; EpiMode E;
    const bool tail8 = (G == 256);
    int gLda;
    if (get_gemm(ph, tail8, a, gA, gLda, gB, gM, gN, gK, E)) {
#ifndef NO_GEMM
      run_gemm(lds, gA, gLda ? gLda : gK, gB, gM, gN, gK, E);
#endif
      if (ph == 1 || ph == 5 || ph == 8 || ph == 17) {
        const int nwg_ = (gM / 256) * (gN / 256), rem_ = nwg_ % G;
        int li_ = (int)blockIdx.x, nl_ = G;
        if (rem_ != 0) { li_ = (int)blockIdx.x - rem_; nl_ = li_ >= 0 ? G - rem_ : 0; }
        if (nl_ > 0) {
          LAS float* scr = (LAS float*)(lds + wave * 16640);
          const int w0 = li_ * 8 + wave, nw = nl_ * 8;
          if (ph == 1) {
            constexpr int I1 = 32 * 32, I2 = 32 * 8, I3 = 32 * 9, I4 = 8 * 48, I5 = 8 * 32, I6 = 8 * 32, I7 = 32 * 32, I8 = 32 * 128;
            constexpr int NIT = I1 + I2 + I3 + I4 + I5 + I6 + I7 + I8;
            for (int it = w0; it < NIT; it += nw) {
              int r = it;
              if (r < I1) { transpose_item<0>(a.in[11], 2048, 2048, (bf16*)(ws + W_AO), 0, scr, r, lane); continue; } r -= I1;
              if (r < I2) { transpose_item<0>(a.in[13], 2048, 512, (bf16*)(ws + W_D), 0, scr, r, lane, a.in[6] + DM); continue; } r -= I2;
              if (r < I3) { transpose_item<0>(a.in[16], 2048, 576, (bf16*)(ws + W_D), 512, scr, r, lane, a.in[6] + DM); continue; } r -= I3;
              if (r < I4) { transpose_item<1>(a.in[15], 512, 3072, (bf16*)(ws + W_UQ), 0, scr, r, lane); continue; } r -= I4;
              if (r < I5) { transpose_item<0>(a.in[18], 512, 2048, (bf16*)(ws + W_UKV), 0, scr, r, lane); continue; } r -= I5;
              if (r < I6) { transpose_item<0>(a.in[19], 512, 2048, (bf16*)(ws + W_UKV), 2048, scr, r, lane); continue; } r -= I6;
              if (r < I7) { transpose_item<0>(a.in[20], 2048, 2048, (bf16*)(ws + W_MO), 0, scr, r, lane); continue; } r -= I7;
              transpose_item<0>(a.in[21], 2048, 8192, (bf16*)(ws + W_F1), 0, scr, r, lane, a.in[8]);
            }
          } else if (ph == 5) {
            for (int it = w0; it < 128 * 32; it += nw) transpose_item<0>(a.in[22], 8192, 2048, (bf16*)(ws + W_F2), 0, scr, it, lane);
          } else if (ph == 8) {
            for (int it = w0; it < 32 * 128; it += nw) transpose_item<0>(a.in[21] + (size_t)2048 * 8192, 2048, 8192, (bf16*)(ws + W_F1), 0, scr, it, lane, a.in[8] + DM);
          } else {
            for (int it = w0; it < 128 * 32; it += nw) transpose_item<0>(a.in[22] + (size_t)2048 * 8192, 8192, 2048, (bf16*)(ws + W_F2), 0, scr, it, lane);
          }
        }
      }
    } else if (ph == 0 || ph == 7) {
      LAS float* scr = (LAS float*)(lds + wave * 16640);
      if (ph == 0) {
        for (int it = gw; it < 32 * 96; it += NGW) transpose_item<0>(a.in[10], 2048, 6144, (bf16*)(ws + W_QKV), 0, scr, it, lane, a.in[6]);
        { u32x4* z = (u32x4*)((bf16*)(ws + W_D) + (size_t)1088 * 2048); const size_t n16 = (size_t)192 * 2048 * 2 / 16;
          u32x4 zv = {0u, 0u, 0u, 0u}; asm volatile("" : "+v"(zv));
          for (size_t i = gt; i < n16; i += NGT) z[i] = zv; }
        { const size_t ng = (size_t)16 * 512 * 256;
#define CVT_A_LD(i, va, vb) const int isv##va = (i) >= ng; const size_t g##va = isv##va ? (i) - ng : (i); const float* s##va = a.in[isv##va ? 3 : 2] + g##va * 8; const f32x4 va = *(const f32x4*)s##va, vb = *(const f32x4*)(s##va + 4)
#define CVT_A_ST(va, vb) *(u32x4*)((bf16*)(ws + (isv##va ? A_VS : A_KS)) + (g##va / (512 * 256)) * 576 * 2048 + (g##va % (512 * 256)) * 8) = pack8(va, vb)
          size_t i = gt;
          for (; i + 3 * NGT < 2 * ng; i += 4 * NGT) { CVT_A_LD(i, p0, p1); CVT_A_LD(i + NGT, q0, q1); CVT_A_LD(i + 2 * NGT, r0, r1); CVT_A_LD(i + 3 * NGT, t0, t1);
            CVT_A_ST(p0, p1); CVT_A_ST(q0, q1); CVT_A_ST(r0, r1); CVT_A_ST(t0, t1); }
          for (; i < 2 * ng; i += NGT) { CVT_A_LD(i, p0, p1); CVT_A_ST(p0, p1); }
#undef CVT_A_LD
#undef CVT_A_ST
        }
        for (int m = gw; m < MT; m += NGW) row_x_prep(xin_row(a, m), xb_row(outp, m), (float*)(ws + A_RSTD) + m, lane);
      } else {
        for (int m = gw; m < MT; m += NGW)
          row_resid_norm<true, true>((const bf16*)(ws + A_T) + (size_t)m * DM, tail8 ? (const bf16*)(ws + A_PF) + (size_t)(m - NPR) * DM : (const bf16*)(ws + A_H) + (size_t)m * DM, tail8 ? (m < NPR ? 0 : 8) : 1, xb_row(outp, m), xb_row(outp, m), a.in[9], (float*)(ws + A_RSTD) + m, lane);
      }
    } else if (ph == 4) {
      for (int m = gw; m < MT; m += NGW)
        row_resid_norm<true, true>((const bf16*)(ws + A_T) + (size_t)m * DM, (const bf16*)(ws + A_Q0) + (size_t)(m - NPR) * DM, (tail8 && m >= NPR) ? 8 : 0, xb_row(outp, m), xb_row(outp, m), a.in[7], (float*)(ws + A_RSTD) + m, lane);
    } else if (ph == 16) {
      for (int m = gw; m < MT; m += NGW)
        row_resid_norm<true, true>((const bf16*)(ws + A_T) + (size_t)m * DM, (const bf16*)(ws + A_QM) + (size_t)(m - NPR) * DM, (tail8 && m >= NPR) ? 8 : 0, xb_row(outp, m), xb_row(outp, m), a.in[7] + DM, (float*)(ws + A_RSTD) + m, lane);
    } else if (ph == 19) {
      for (int m = gw; m < MT; m += NGW)
        row_resid_norm<true, false>((const bf16*)(ws + A_T) + (size_t)m * DM, tail8 ? (const bf16*)(ws + A_PF) + (size_t)(m - NPR) * DM : (const bf16*)(ws + A_H) + (size_t)m * DM, tail8 ? (m < NPR ? 0 : 8) : 1, xb_row(outp, m), outp + (size_t)m * DM, a.in[9] + DM, nullptr, lane);
    } else if (ph == 9) {
      for (int m = gw; m < MT; m += NGW) row_mla((const bf16*)(ws + A_DQ) + (size_t)m * 1280, m, a.in[14], a.in[17], ws, outp, lane);
      { const size_t ng = (size_t)16 * 2048 * 64;
#define CVT_C_LD(i, va, vb) const size_t g##va = (i); const float* s##va = a.in[4] + g##va * 8; const f32x4 va = *(const f32x4*)s##va, vb = *(const f32x4*)(s##va + 4)
#define CVT_C_ST(va, vb) *(u32x4*)((bf16*)(ws + A_CKVS) + (g##va / (2048 * 64)) * 2112 * 512 + (g##va % (2048 * 64)) * 8) = pack8(va, vb)
        size_t i = gt;
        for (; i + 3 * NGT < ng; i += 4 * NGT) { CVT_C_LD(i, p0, p1); CVT_C_LD(i + NGT, q0, q1); CVT_C_LD(i + 2 * NGT, r0, r1); CVT_C_LD(i + 3 * NGT, t0, t1);
          CVT_C_ST(p0, p1); CVT_C_ST(q0, q1); CVT_C_ST(r0, r1); CVT_C_ST(t0, t1); }
        for (; i < ng; i += NGT) { CVT_C_LD(i, p0, p1); CVT_C_ST(p0, p1); }
#undef CVT_C_LD
#undef CVT_C_ST
      }
      { const size_t ng = (size_t)16 * 2048 * 8;
        for (size_t i = gt; i < ng; i += NGT) { const size_t rowi = i >> 3; const int q = (int)(i & 7); const size_t b = rowi / 2048, r = rowi % 2048;
          const float* src = a.in[5] + rowi * 64 + 4 * q; const f32x4 x1 = *(const f32x4*)src, x2 = *(const f32x4*)(src + 32);
          u32x4 w; w.x = cvtpk(x1.x, x2.x); w.y = cvtpk(x1.y, x2.y); w.z = cvtpk(x1.z, x2.z); w.w = cvtpk(x1.w, x2.w);
          *(u32x4*)((bf16*)(ws + A_KRS) + (b * 2112 + r) * 64 + 8 * q) = w; } }
    } else if (ph == 2) {
      const float C = 0.08838834764831845f * LOG2E;
      for (int u = blockIdx.x; u < 1280; u += G) {
        att::Unit U; U.Qr = nullptr; U.KR = nullptr; U.ldq = 2048; U.ldk = 2048; U.ldo = 2048;
        if (u < 1024) { const int h = u & 15, qb = (u >> 4) & 15, b = u >> 8, c0 = qb * 4, kc0 = c0 > 8 ? c0 - 8 : 0;
          const size_t rq = (size_t)b * 4096 + qb * 256, rk = (size_t)b * 4096 + kc0 * 64;
          U.Q = (const bf16*)(ws + A_Q0) + rq * 2048 + h * 128; U.K = (const bf16*)(ws + A_KP) + rk * 2048 + h * 128; U.V = (const bf16*)(ws + A_VP) + rk * 2048 + h * 128;
          U.O = (bf16*)(ws + A_O0) + rq * 2048 + h * 128; U.nt = c0 + 4 - kc0; U.nact = 8; U.thi0 = c0 - kc0; U.tlo0 = c0 - 8 - kc0; U.qrel0 = (c0 - kc0) * 64; U.bias = a.in[12] + h * 513;
        } else { const int us = u - 1024, h = us & 15, b = us >> 4; const size_t rq = (size_t)NPR + b * 64;
          U.Q = (const bf16*)(ws + A_Q0) + rq * 2048 + h * 128; U.K = (const bf16*)(ws + A_KS) + (size_t)b * 576 * 2048 + h * 128; U.V = (const bf16*)(ws + A_VS) + (size_t)b * 576 * 2048 + h * 128;
          U.O = (bf16*)(ws + A_O0) + rq * 2048 + h * 128; U.nt = 9; U.nact = 2; U.thi0 = 8; U.tlo0 = 0; U.qrel0 = 512; U.bias = a.in[12] + h * 513; }
#ifndef NO_BAND
        att::attn_unit<true, BAND_SD>(U, (LAS char*)lds, C);
#endif
      }
    } else if (ph == 12 || ph == 14) {
      const float C = 0.07216878364870322f * LOG2E;
      const int nunits = ph == 12 ? 1024 : 256;
      for (int i = blockIdx.x; i < nunits; i += G) {
        att::Unit U; U.ldq = 3072; U.ldk = 4096; U.ldo = 2048; U.bias = nullptr; U.qrel0 = 0; U.tlo0 = -100000;
        if (ph == 12) { const int rnd = i >> 8, v = i & 255, bh = v >> 2, s = v & 3, qb = rnd == 0 ? s : rnd == 1 ? 7 - s : rnd == 2 ? 8 + s : 15 - s, b = bh >> 4, h = bh & 15;
          const size_t rq = (size_t)b * 4096 + qb * 256, rk = (size_t)b * 4096;
          U.Q = (const bf16*)(ws + A_QM) + rq * 3072 + h * 128; U.Qr = (const bf16*)(ws + A_QM) + rq * 3072 + 2048 + h * 64;
          U.K = (const bf16*)(ws + A_KNV) + rk * 4096 + h * 128; U.V = (const bf16*)(ws + A_KNV) + rk * 4096 + 2048 + h * 128; U.KR = (const bf16*)(ws + A_KRP) + rk * 64;
          U.O = (bf16*)(ws + A_O1) + rq * 2048 + h * 128; U.nt = qb * 4 + 4; U.nact = 8; U.thi0 = qb * 4;
        } else { const int b = i >> 4, h = i & 15; const size_t rq = (size_t)NPR + b * 64, rk = (size_t)b * 2112;
          U.Q = (const bf16*)(ws + A_QM) + rq * 3072 + h * 128; U.Qr = (const bf16*)(ws + A_QM) + rq * 3072 + 2048 + h * 64;
          U.K = (const bf16*)(ws + A_KNV) + rk * 4096 + h * 128; U.V = (const bf16*)(ws + A_KNV) + rk * 4096 + 2048 + h * 128; U.KR = (const bf16*)(ws + A_KRS) + rk * 64;
          U.O = (bf16*)(ws + A_O1) + rq * 2048 + h * 128; U.nt = 33; U.nact = 2; U.thi0 = 32; }
#ifndef NO_MLA
        att::attn_unit<false, MLA_SD>(U, (LAS char*)lds, C);
#endif
      }
    }
    if (it_ + 1 < a_.ph_hi && ph != 10) { if (a_.ph_hi > 1000) grid.sync(); else xcd_barrier(xbar);
      for (int e_ = 0; e_ < PROBE_SYNC; ++e_) xcd_barrier(xbar); }
  }
}

#ifndef MULTI_LAUNCH
#define MULTI_LAUNCH 0
#endif
extern "C" void kernel_launch(void* const* d_in, const int* in_sizes, int n_in, void* d_out, int out_size, void* d_ws, size_t ws_size, hipStream_t stream) {
  static int grid = 0;
  if (grid == 0) {
    if (n_in != 23 || out_size != (int)O_END || ws_size < WS_NEED) { fprintf(stderr, "kernel_launch: unexpected shapes n_in %d out %d ws %zu (need %zu)\n", n_in, out_size, ws_size, (size_t)WS_NEED); grid = -1; return; }
    int dev = 0, cus = 0, per_cu = 0;
    hipGetDevice(&dev); hipDeviceGetAttribute(&cus, hipDeviceAttributeMultiprocessorCount, dev);
    if (hipFuncSetAttribute((const void*)fwd_mega, hipFuncAttributeMaxDynamicSharedMemorySize, LDS_BYTES) != hipSuccess) { fprintf(stderr, "hipFuncSetAttribute failed\n"); grid = -1; return; }
    hipOccupancyMaxActiveBlocksPerMultiprocessor(&per_cu, (const void*)fwd_mega, 512, LDS_BYTES);
    (void)hipGetLastError();
    if (per_cu < 1) per_cu = 1;
    grid = cus;
  }
  if (grid < 0) return;
  if (hipMemsetAsync((char*)d_ws + A_BAR, 0, 16384, stream) != hipSuccess) { fprintf(stderr, "memset failed\n"); return; }
  Args a{};
  for (int i = 0; i < 23; ++i) a.in[i] = (const float*)d_in[i];
  a.out = (float*)d_out; a.ws = (unsigned char*)d_ws;
#if MULTI_LAUNCH
  for (int ph = 0; ph < NSTEPS; ++ph) { a.ph_lo = ph; a.ph_hi = ph + 1; hipLaunchKernelGGL(fwd_mega, dim3(grid), dim3(512), LDS_BYTES, stream, a); }
#else
  a.ph_lo = 0; a.ph_hi = NSTEPS + PROBE_REP;
  void* args[] = {&a};
  hipError_t e = hipLaunchCooperativeKernel((const void*)fwd_mega, dim3(grid), dim3(512), args, LDS_BYTES, stream);
  if (e != hipSuccess) fprintf(stderr, "cooperative launch failed: %s (grid %d)\n", hipGetErrorString(e), grid);
#endif
}
```

```cpp
#include <hip/hip_runtime.h>
#include <hip/hip_cooperative_groups.h>
#include <cstdio>
#include <cstdint>
namespace cg = cooperative_groups;
namespace pg8 {
#define PG8_LAS __attribute__((address_space(3)))
typedef unsigned short bf16_t;
typedef short bf16x8 __attribute__((ext_vector_type(8)));
typedef float f32x4 __attribute__((ext_vector_type(4)));
typedef unsigned u32x4 __attribute__((ext_vector_type(4)));
constexpr int BM = 256, BK = 64, HALF = 128, HTB = HALF * BK * 2  , STAGE_BYTES = 8 * HTB, NXCD = 8, WGM = 8;

__host__ __device__ __forceinline__ int lds_byte(int r, int c) { const int st = (r >> 4) * 2 + (c >> 5), rr = r & 15, cc = c & 31, ob = rr * 64 + cc * 2; return st * 1024 + (ob ^ (((ob >> 9) & 1) << 5)); }
__host__ __device__ __forceinline__ void stage_rc(int b, int& R, int& C) { const int st = b / 1024, sb = b % 1024, swz = sb ^ (((sb >> 9) & 1) << 5); R = (st >> 1) * 16 + swz / 64; C = (st & 1) * 32 + (swz % 64) / 2; }
__host__ __device__ __forceinline__ int perm32(int rho) { const int n = rho >> 4, i = rho & 15; return 8 * (i >> 2) + 4 * n + (i & 3); }

struct Unit { int pm, pn, kb, nk, part; };
struct Gemm { const bf16_t* A; const bf16_t* Bt; int M, N, K, lda; };

struct StaticOrder {
    int nM, nN, nwg, G, c, KT, ns;
    __host__ __device__ __forceinline__ void init(int M, int N, int K, int G_, int c_, int ns_) { nM = M / BM; nN = N / BM; nwg = nM * nN; G = G_; c = c_; KT = K / BK; ns = ns_; }
    __host__ __device__ __forceinline__ bool next(int i, Unit& uo) const {
        if (ns == 8) {
            const int L = i * G + c; Unit u;
            if (L < 512) {
                int wgid = L; { const int q = 512 / NXCD, xcd = wgid % NXCD, off = wgid / NXCD; wgid = xcd * q + off; }
                const int nig = WGM * nN; const int gid = wgid / nig, fm = gid * WGM;
                u.pm = fm + ((wgid % nig) / nN); u.pn = (wgid % nig) % nN; u.kb = 0; u.nk = KT; u.part = 2;
            } else {
                const int q = L - 512, t = q % 32, kp = q / 32;
                u.pm = 64 + t / 8; u.pn = t % 8; u.nk = KT / 8; u.kb = kp * u.nk; u.part = 16 + kp;
            }
            uo = u; return L < 768;
        }
        const int np = nwg * ns;
        const int L = i * G + c; const bool ok = L < np;
        int wgid = L; { const int q = np / NXCD, r = np % NXCD, xcd = wgid % NXCD, off = wgid / NXCD; wgid = (xcd < r ? xcd * (q + 1) : r * (q + 1) + (xcd - r) * q) + off; }
        const int half = wgid >= nwg ? 1 : 0; wgid -= half * nwg;
        const int nig = WGM * nN, gid = wgid / nig, fm = gid * WGM, gsz = (nM - fm) < WGM ? (nM - fm) : WGM;
        Unit u; u.pm = fm + ((wgid % nig) % gsz); u.pn = (wgid % nig) / gsz; u.nk = KT / ns; u.kb = half * u.nk; u.part = ns == 2 ? half : 2;
        uo = u; return ok;
    }
    __device__ __forceinline__ void a_ready(const Unit&) const {}
    __device__ __forceinline__ void done(const Unit&) const {}
};
__device__ __forceinline__ unsigned cvt_pk_bf16(float lo, float hi) { unsigned r; asm volatile("v_cvt_pk_bf16_f32 %0, %1, %2" : "=v"(r) : "v"(lo), "v"(hi)); return r; }
template <class Epi, class Sched, bool ALIGN_EPI = false, bool SP2 = false>
__device__ __forceinline__ void gemm_phase(PG8_LAS unsigned char* lds, const Gemm g, const Sched& S, const Epi& E) {
    int tid = threadIdx.x; asm volatile("" : "+v"(tid)); const int wid = __builtin_amdgcn_readfirstlane(tid >> 6), lane = tid & 63, wr = wid >> 2, wc = wid & 3, fr = lane & 15, fq = lane >> 4;
    const int K = g.K;
    unsigned voffA[2], voffB[2];
#pragma unroll
    for (int i = 0; i < 2; ++i) { int R, C; stage_rc(tid * 16 + i * 8192, R, C); const int Rb = Epi::PERM ? ((R & ~31) + perm32(R & 31)) : R;
        voffA[i] = (unsigned)(R * g.lda + C) * 2u; voffB[i] = (unsigned)(Rb * K + C) * 2u; }
    const size_t kstep = (size_t)(BK * 2);
    const size_t hstep = (size_t)HALF * K * 2;
    const size_t tstep = 2 * hstep;
    const size_t hstepA = (size_t)HALF * g.lda * 2, tstepA = 2 * hstepA;
    const unsigned ldsw = (unsigned)wid * 1024u;
    const int aoff = lds_byte(wr * 64 + fr, fq * 8), boff = lds_byte(wc * 32 + fr, fq * 8);
#define PG8_SA(b, h) (((b) * 2 + (h)) * HTB)
#define PG8_SB(b, h) ((4 + (b) * 2 + (h)) * HTB)
#define PG8_STAGE(bufoff, gbase, voff) do { _Pragma("unroll") for (int _i = 0; _i < 2; ++_i) \
        __builtin_amdgcn_global_load_lds((const unsigned*)((const char*)(gbase) + (voff)[_i]), (PG8_LAS unsigned*)(lds + (bufoff) + ldsw + _i * 8192), 16, 0, 0); } while (0)
#define PG8_LDA(dst, b, h) do { _Pragma("unroll") for (int m = 0; m < 4; ++m) _Pragma("unroll") for (int k = 0; k < 2; ++k) dst[m][k] = *(const PG8_LAS bf16x8*)(lds + PG8_SA(b, h) + aoff + m * 2048 + k * 1024); } while (0)
#define PG8_LDB(dst, b, h) do { _Pragma("unroll") for (int n = 0; n < 2; ++n) _Pragma("unroll") for (int k = 0; k < 2; ++k) dst[n][k] = *(const PG8_LAS bf16x8*)(lds + PG8_SB(b, h) + boff + n * 2048 + k * 1024); } while (0)
#define PG8_MMA(ai, bj, At, Bt) do { __builtin_amdgcn_s_setprio(1); _Pragma("unroll") for (int m = 0; m < 4; ++m) _Pragma("unroll") for (int n = 0; n < 2; ++n) _Pragma("unroll") for (int k = 0; k < 2; ++k) \
        acc[ai][bj][m][n] = __builtin_amdgcn_mfma_f32_16x16x32_bf16(Bt[n][k], At[m][k], acc[ai][bj][m][n], 0, 0, 0); __builtin_amdgcn_s_setprio(0); } while (0)
#define PG8_WAIT_V(n) asm volatile("s_waitcnt vmcnt(" #n ")" ::: "memory")
#define PG8_WAIT_L(n) asm volatile("s_waitcnt lgkmcnt(" #n ")" ::: "memory")
#define PG8_BAR __builtin_amdgcn_s_barrier()
#define PG8_SCHED __builtin_amdgcn_sched_barrier(0)
    Unit cur, nxt; int ui = 0;
    if (!S.next(0, cur)) return;
    f32x4 acc[2][2][4][2];
#pragma unroll
    for (int a = 0; a < 2; ++a)
#pragma unroll
        for (int b = 0; b < 2; ++b)
#pragma unroll
            for (int m = 0; m < 4; ++m)
#pragma unroll
                for (int n = 0; n < 2; ++n) acc[a][b][m][n] = (f32x4){0.f, 0.f, 0.f, 0.f};
    bf16x8 At[4][2], B0[2][2], B1[2][2];
    const char* cA = (const char*)g.A + (size_t)cur.pm * tstepA + (size_t)cur.kb * kstep; const char* cB = (const char*)g.Bt + (size_t)cur.pn * tstep + (size_t)cur.kb * kstep;
    S.a_ready(cur);
    if constexpr (SP2) {
        PG8_STAGE(PG8_SB(0, 0), cB, voffB); PG8_STAGE(PG8_SB(0, 1), cB + hstep, voffB); PG8_STAGE(PG8_SA(0, 0), cA, voffA); PG8_STAGE(PG8_SA(0, 1), cA + hstepA, voffA);
        if (wr == 1) PG8_BAR;
        PG8_WAIT_V(2); PG8_BAR;
        PG8_STAGE(PG8_SB(1, 0), cB + kstep, voffB); PG8_STAGE(PG8_SA(1, 0), cA + kstep, voffA); PG8_STAGE(PG8_SB(1, 1), cB + hstep + kstep, voffB);
        PG8_WAIT_V(6); PG8_BAR;
    } else {
        PG8_STAGE(PG8_SB(0, 0), cB, voffB); PG8_STAGE(PG8_SA(0, 0), cA, voffA); PG8_STAGE(PG8_SB(0, 1), cB + hstep, voffB); PG8_STAGE(PG8_SA(0, 1), cA + hstepA, voffA);
        if (wr == 1) PG8_BAR;
        PG8_WAIT_V(4); PG8_BAR;
        PG8_STAGE(PG8_SB(1, 0), cB + kstep, voffB); PG8_STAGE(PG8_SA(1, 0), cA + kstep, voffA); PG8_STAGE(PG8_SB(1, 1), cB + hstep + kstep, voffB);
        PG8_WAIT_V(6); PG8_BAR;
    }
    for (;;) {
        const bool has_next = S.next(ui + 1, nxt);
        const char* nA = has_next ? (const char*)g.A + (size_t)nxt.pm * tstepA + (size_t)nxt.kb * kstep : cA; const char* nB = has_next ? (const char*)g.Bt + (size_t)nxt.pn * tstep + (size_t)nxt.kb * kstep : cB;
        const int nt = cur.nk;
        for (int t = 0; t < nt; t += 2) {
            const bool last = (t == nt - 2);
            const char* a1 = cA + (size_t)(t + 1) * kstep;
            const char* a2 = last ? nA : cA + (size_t)(t + 2) * kstep; const char* b2 = last ? nB : cB + (size_t)(t + 2) * kstep;
            const char* a3 = a2 + kstep; const char* b3 = b2 + kstep;
            if (last && has_next) S.a_ready(nxt);
            if constexpr (SP2) {
            PG8_LDB(B0, 0, 0); PG8_LDB(B1, 0, 1); PG8_SCHED; PG8_LDA(At, 0, 0); PG8_STAGE(PG8_SA(1, 1), a1 + hstepA, voffA);
            PG8_WAIT_V(8); PG8_WAIT_L(0); PG8_BAR; PG8_MMA(0, 0, At, B0); PG8_MMA(0, 1, At, B1); PG8_BAR; PG8_SCHED;
            PG8_LDA(At, 0, 1); PG8_STAGE(PG8_SB(0, 0), b2, voffB); PG8_STAGE(PG8_SB(0, 1), b2 + hstep, voffB); PG8_STAGE(PG8_SA(0, 0), a2, voffA);
            PG8_WAIT_V(8); PG8_WAIT_L(0); PG8_BAR; PG8_MMA(1, 0, At, B0); PG8_MMA(1, 1, At, B1); PG8_BAR; PG8_SCHED;
            PG8_LDB(B0, 1, 0); PG8_LDB(B1, 1, 1); PG8_SCHED; PG8_LDA(At, 1, 0); PG8_STAGE(PG8_SA(0, 1), a2 + hstepA, voffA);
            PG8_WAIT_V(8); PG8_WAIT_L(0); PG8_BAR; PG8_MMA(0, 0, At, B0); PG8_MMA(0, 1, At, B1); PG8_BAR; PG8_SCHED;
            PG8_LDA(At, 1, 1); PG8_STAGE(PG8_SB(1, 0), b3, voffB); PG8_STAGE(PG8_SB(1, 1), b3 + hstep, voffB); PG8_STAGE(PG8_SA(1, 0), a3, voffA);
            PG8_WAIT_V(8); PG8_WAIT_L(0); PG8_BAR; PG8_MMA(1, 0, At, B0); PG8_MMA(1, 1, At, B1); PG8_BAR; PG8_SCHED;
            } else {
            PG8_LDB(B0, 0, 0); PG8_SCHED; PG8_LDA(At, 0, 0); PG8_STAGE(PG8_SA(1, 1), a1 + hstepA, voffA);
            PG8_WAIT_L(8); PG8_BAR; PG8_WAIT_L(0); PG8_MMA(0, 0, At, B0); PG8_BAR; PG8_SCHED;
            PG8_LDB(B1, 0, 1); PG8_STAGE(PG8_SB(0, 0), b2, voffB);
            PG8_BAR; PG8_WAIT_L(0); PG8_MMA(0, 1, At, B1); PG8_BAR;
            PG8_LDA(At, 0, 1); PG8_STAGE(PG8_SA(0, 0), a2, voffA);
            PG8_BAR; PG8_WAIT_L(0); PG8_MMA(1, 0, At, B0); PG8_BAR; PG8_SCHED;
            PG8_STAGE(PG8_SB(0, 1), b2 + hstep, voffB);
            PG8_WAIT_V(6); PG8_BAR; PG8_MMA(1, 1, At, B1); PG8_BAR;
            PG8_LDB(B0, 1, 0); PG8_SCHED; PG8_LDA(At, 1, 0); PG8_STAGE(PG8_SA(0, 1), a2 + hstepA, voffA);
            PG8_WAIT_L(8); PG8_BAR; PG8_WAIT_L(0); PG8_MMA(0, 0, At, B0); PG8_BAR; PG8_SCHED;
            PG8_LDB(B1, 1, 1); PG8_STAGE(PG8_SB(1, 0), b3, voffB);
            PG8_BAR; PG8_WAIT_L(0); PG8_MMA(0, 1, At, B1); PG8_BAR;
            PG8_LDA(At, 1, 1); PG8_STAGE(PG8_SA(1, 0), a3, voffA);
            PG8_BAR; PG8_WAIT_L(0); PG8_MMA(1, 0, At, B0); PG8_BAR; PG8_SCHED;
            PG8_STAGE(PG8_SB(1, 1), b3 + hstep, voffB);
            PG8_WAIT_V(6); PG8_BAR; PG8_MMA(1, 1, At, B1); PG8_BAR;
            }
        }
        if constexpr (ALIGN_EPI) { if (wr == 0) PG8_BAR; }
        if constexpr (!Epi::AFTER_DRAIN) { E(acc, cur, wr, wc, fr, fq); S.done(cur); }
        if (!has_next) break;
#pragma unroll
        for (int a = 0; a < 2; ++a)
#pragma unroll
            for (int b = 0; b < 2; ++b)
#pragma unroll
                for (int m = 0; m < 4; ++m)
#pragma unroll
                    for (int n = 0; n < 2; ++n) acc[a][b][m][n] = (f32x4){0.f, 0.f, 0.f, 0.f};
        cur = nxt; cA = nA; cB = nB; ++ui;
        if constexpr (ALIGN_EPI) { if (wr == 1) PG8_BAR; }
    }
    PG8_WAIT_V(0);
    if constexpr (!ALIGN_EPI) { if (wr == 0) PG8_BAR; }
    PG8_BAR;
    if constexpr (Epi::AFTER_DRAIN) { E.fused(acc, cur, wr, wc, fr, fq, lds, wid, lane); S.done(cur); }
#undef PG8_SA
#undef PG8_SB
#undef PG8_STAGE
#undef PG8_LDA
#undef PG8_LDB
#undef PG8_MMA
#undef PG8_WAIT_V
#undef PG8_WAIT_L
#undef PG8_BAR
#undef PG8_SCHED
}
}
#define LAS __attribute__((address_space(3)))
#define DI __device__ __forceinline__
typedef unsigned short bf16;
typedef float f32x4 __attribute__((ext_vector_type(4)));
typedef float f32x8 __attribute__((ext_vector_type(8)));
typedef float f32x16 __attribute__((ext_vector_type(16)));
typedef short bf16x8 __attribute__((ext_vector_type(8)));
typedef short s16x4 __attribute__((ext_vector_type(4)));
typedef unsigned u32x4 __attribute__((ext_vector_type(4)));
typedef unsigned u32x2 __attribute__((ext_vector_type(2)));

constexpr int DM = 2048, NPR = 16384, NSA = 1024, MT = NPR + NSA, SEQ = 4096, DEC = 64, PAST = 2048, DFF = 8192;
constexpr float EPS = 1e-6f;
constexpr float LOG2E = 1.4426950408889634f;

constexpr size_t O_Y = 0, O_AKP = 35651584, O_AVP = 39845888, O_AKS = 44040192, O_AVS = 46137344,
                 O_CKVP = 48234496, O_KRP = 56623104, O_CKVS = 57671680, O_KRS = 58195968, O_END = 58261504;
constexpr size_t MiB = 1u << 20;
constexpr size_t W_QKV = 0, W_AO = 24 * MiB, W_D = 32 * MiB, W_UQ = 37 * MiB, W_UKV = 40 * MiB, W_MO = 44 * MiB, W_F1 = 52 * MiB, W_F2 = 84 * MiB;
constexpr size_t A_H = 116 * MiB, A_T = 184 * MiB, A_R = 252 * MiB;
constexpr size_t A_Q0 = A_R, A_KP = A_R + 68 * MiB, A_VP = A_KP + 64 * MiB, A_KS = A_VP + 64 * MiB, A_VS = A_KS + 36 * MiB, A_O0 = A_VS + 36 * MiB;
constexpr size_t A_PF = 528 * MiB;
constexpr size_t A_HID = A_R;
constexpr size_t A_CKVP = A_R, A_CKVS = A_R + 16 * MiB, A_KRP = A_CKVS + 33 * MiB, A_KRS = A_KRP + 2 * MiB, A_QM = A_KRS + 5 * MiB, A_KNV = A_QM + 102 * MiB;
constexpr size_t A_DQ = A_KNV, A_CQ = A_KNV + 130 * MiB, A_O1 = A_H;
constexpr size_t A_BAR = A_KNV + 264 * MiB;
constexpr size_t A_RSTD = A_BAR + 65536;
constexpr size_t WS_NEED = A_RSTD + 131072;

DI unsigned cvtpk(float lo, float hi) { unsigned r; asm volatile("v_cvt_pk_bf16_f32 %0, %1, %2" : "=v"(r) : "v"(lo), "v"(hi)); return r; }
DI float bflo(unsigned w) { return __uint_as_float(w << 16); }
DI float bfhi(unsigned w) { return __uint_as_float(w & 0xffff0000u); }
DI float wave_sum(float v) {
  v += __int_as_float(__builtin_amdgcn_ds_swizzle(__float_as_int(v), (1 << 10) | 0x1f));
  v += __int_as_float(__builtin_amdgcn_ds_swizzle(__float_as_int(v), (2 << 10) | 0x1f));
  v += __int_as_float(__builtin_amdgcn_ds_swizzle(__float_as_int(v), (4 << 10) | 0x1f));
  v += __int_as_float(__builtin_amdgcn_ds_swizzle(__float_as_int(v), (8 << 10) | 0x1f));
  v += __int_as_float(__builtin_amdgcn_ds_swizzle(__float_as_int(v), (16 << 10) | 0x1f));
  auto rr = __builtin_amdgcn_permlane32_swap(__float_as_uint(v), __float_as_uint(v), false, false);
  return __uint_as_float(rr[0]) + __uint_as_float(rr[1]);
}
DI u32x4 pack8(f32x4 a, f32x4 b) { u32x4 w; w.x = cvtpk(a.x, a.y); w.y = cvtpk(a.z, a.w); w.z = cvtpk(b.x, b.y); w.w = cvtpk(b.z, b.w); return w; }


DI void sincos_cw(float x, float& sn, float& cs) {
  const float k = rintf(x * 0.63661977236758134f);
  float r = fmaf(-k, 1.5703125f, x); r = fmaf(-k, 4.837512969970703125e-4f, r); r = fmaf(-k, 7.54978995489188216e-8f, r);
  const float z = r * r;
  const float sp = fmaf(r * z, fmaf(z, fmaf(z, -1.9515295891e-4f, 8.3321608736e-3f), -1.6666654611e-1f), r);
  const float cp = fmaf(z * z, fmaf(z, fmaf(z, 2.443315711809948e-5f, -1.388731625493765e-3f), 4.166664568298827e-2f), fmaf(z, -0.5f, 1.0f));
  const int q = ((int)k) & 3;
  const float s1 = (q & 1) ? cp : sp, c1 = (q & 1) ? sp : cp;
  sn = (q & 2) ? -s1 : s1; cs = ((q + 1) & 2) ? -c1 : c1;
}
enum { EM_BF16 = 0, EM_QKV = 1, EM_RELU2 = 2, EM_F32 = 3, EM_QROPE = 4, EM_SPLIT = 5, EM_TAIL = 6 };
struct EpiMode {
  static constexpr bool PERM = true, AFTER_DRAIN = false;
  int mode; bf16* O; int ldc; float* F; float* outp;
  bf16* O2;
  const float* rs;
  unsigned char* ws;
  template <int MODE> DI void store8(int row, int col, f32x4 v0, f32x4 v1, int part) const {
    if (MODE == EM_QKV || MODE == EM_RELU2 || MODE == EM_F32) { const float r_ = rs[row]; v0 *= r_; v1 *= r_; }
    if (MODE == EM_TAIL) {
      if (part >= 16) *(u32x4*)(O2 + ((size_t)(part - 16) * 1024 + (row - NPR)) * 2048 + col) = pack8(v0, v1);
      else *(u32x4*)(O + (size_t)row * ldc + col) = pack8(v0, v1);
    } else if (MODE == EM_SPLIT) {
      bf16* d = (part & 1) ? O2 : O; *(u32x4*)(d + (size_t)row * ldc + col) = pack8(v0, v1);
      if (part & 2) *(u32x4*)(O2 + (size_t)row * ldc + col) = (u32x4){0u, 0u, 0u, 0u};
    } else if (MODE == EM_BF16) { *(u32x4*)(O + (size_t)row * ldc + col) = pack8(v0, v1); }
    else if (MODE == EM_RELU2) {
      f32x4 a = __builtin_elementwise_max(v0, (f32x4){0.f, 0.f, 0.f, 0.f}), b = __builtin_elementwise_max(v1, (f32x4){0.f, 0.f, 0.f, 0.f});
      *(u32x4*)(O + (size_t)row * ldc + col) = pack8(a * a, b * b); }
    else if (MODE == EM_F32) { if (col < 1088) *(u32x4*)((bf16*)F + (size_t)row * ldc + col) = pack8(v0, v1); }
    else if (MODE == EM_QKV) {
      const u32x4 w = pack8(v0, v1);
      if (col < 2048) { *(u32x4*)((bf16*)(ws + A_Q0) + (size_t)row * 2048 + col) = w; }
      else {
        const int isv = col >= 4096; const int c = col - (isv ? 4096 : 2048);
        if (row < NPR) {
          *(u32x4*)((bf16*)(ws + (isv ? A_VP : A_KP)) + (size_t)row * 2048 + c) = w;
          const int s = row & 4095, b = row >> 12;
          if (s >= 3584) { float* p = outp + (isv ? O_AVP : O_AKP) + ((size_t)(b * 512 + s - 3584)) * 2048 + c; *(f32x4*)p = v0; *(f32x4*)(p + 4) = v1; }
        } else {
          const int rs = row - NPR, b = rs >> 6, i = rs & 63;
          *(u32x4*)((bf16*)(ws + (isv ? A_VS : A_KS)) + ((size_t)(b * 576 + 512 + i)) * 2048 + c) = w;
          float* p = outp + (isv ? O_AVS : O_AKS) + (size_t)rs * 2048 + c; *(f32x4*)p = v0; *(f32x4*)(p + 4) = v1;
        }
      }
    } else if (MODE == EM_QROPE) {
      if (col >= 2048) {
        const int j = col - 2048, i0 = (j & 63) >> 1;
        const float pos = (float)(row < NPR ? (row & 4095) : PAST + ((row - NPR) & 63));
        float x[8] = {v0.x, v0.y, v0.z, v0.w, v1.x, v1.y, v1.z, v1.w};
#pragma unroll
        for (int p = 0; p < 4; ++p) {
          const float inv = exp2f(-(float)(i0 + p) * 0.41524101186092029f);
          float sn, cs; sincos_cw(pos * inv, sn, cs);
          const float a = x[2 * p], b = x[2 * p + 1];
          x[2 * p] = a * cs - b * sn; x[2 * p + 1] = b * cs + a * sn;
        }
        v0 = (f32x4){x[0], x[1], x[2], x[3]}; v1 = (f32x4){x[4], x[5], x[6], x[7]};
      }
      *(u32x4*)(O + (size_t)row * ldc + col) = pack8(v0, v1);
    }
  }
  template <int MODE> DI void run(const f32x4 (&acc)[2][2][4][2], const pg8::Unit& u, int wr, int wc, int fr, int fq) const {
#pragma unroll
    for (int ai = 0; ai < 2; ++ai)
#pragma unroll
      for (int m = 0; m < 4; ++m) {
        const int row = u.pm * 256 + ai * 128 + wr * 64 + m * 16 + fr;
#pragma unroll
        for (int bj = 0; bj < 2; ++bj) { store8<MODE>(row, u.pn * 256 + bj * 128 + wc * 32 + 8 * fq, acc[ai][bj][m][0], acc[ai][bj][m][1], u.part);
          if (MODE == EM_QROPE || MODE == EM_QKV) asm volatile("" ::: "memory"); }
      }
  }
  DI void operator()(const f32x4 (&acc)[2][2][4][2], const pg8::Unit& u, int wr, int wc, int fr, int fq) const {
    { int t_ = threadIdx.x; asm volatile("" : "+v"(t_)); fr = t_ & 15; fq = (t_ >> 4) & 3; }
    switch (mode) {
      case EM_BF16: run<EM_BF16>(acc, u, wr, wc, fr, fq); break;
      case EM_RELU2: run<EM_RELU2>(acc, u, wr, wc, fr, fq); break;
      case EM_F32: run<EM_F32>(acc, u, wr, wc, fr, fq); break;
      case EM_QKV: run<EM_QKV>(acc, u, wr, wc, fr, fq); break;
      case EM_SPLIT: run<EM_SPLIT>(acc, u, wr, wc, fr, fq); break;
      case EM_TAIL: run<EM_TAIL>(acc, u, wr, wc, fr, fq); break;
      default: run<EM_QROPE>(acc, u, wr, wc, fr, fq); break;
    }
  }
};
DI void run_gemm(LAS unsigned char* lds, const bf16* A, int lda, const bf16* Bt, int M, int N, int K, const EpiMode& E) {
  pg8::Gemm g{A, Bt, M, N, K, lda}; pg8::StaticOrder S; S.init(M, N, K, (int)gridDim.x, (int)blockIdx.x, E.mode == EM_TAIL ? 8 : E.mode == EM_SPLIT ? 2 : 1);
  pg8::gemm_phase<EpiMode, pg8::StaticOrder, true, true>(lds, g, S, E);
}
DI void row_x_prep(const float* xrow, bf16* xbrow, float* rstd_out, int lane) {
  const f32x4* xr = (const f32x4*)xrow + lane;
  f32x4 v[8]; float s = 0.f;
#pragma unroll
  for (int j = 0; j < 8; ++j) { v[j] = xr[64 * j]; s += (v[j].x * v[j].x + v[j].y * v[j].y) + (v[j].z * v[j].z + v[j].w * v[j].w); }
  const float rstd = rsqrtf(wave_sum(s) * (1.f / DM) + EPS);
  u32x2* x8 = (u32x2*)xbrow + lane;
#pragma unroll
  for (int j = 0; j < 8; ++j) { u32x2 w; w.x = cvtpk(v[j].x, v[j].y); w.y = cvtpk(v[j].z, v[j].w); x8[64 * j] = w; }
  if (lane == 0) *rstd_out = rstd;
}
template <bool XINB, bool XOUTB> DI void row_resid_norm(const bf16* trow, const bf16* trow2, int npart, const void* xin, void* xout, const float* gpost, float* rstd_out, int lane) {
  const u32x2* tr = (const u32x2*)trow + lane; const u32x2* tr2 = (const u32x2*)trow2 + lane; const f32x4* gr = (const f32x4*)gpost + lane;
  f32x4 t[8], x[8]; float s = 0.f;
#pragma unroll
  for (int j = 0; j < 8; ++j) {
    if (npart == 8) { f32x4 acc4 = {0.f, 0.f, 0.f, 0.f};
#pragma unroll
      for (int p = 0; p < 8; ++p) { const u32x2 w = (tr2 + (size_t)p * (1024 * 2048 / 4))[64 * j]; acc4 += (f32x4){bflo(w.x), bfhi(w.x), bflo(w.y), bfhi(w.y)}; }
      t[j] = acc4;
    } else { const u32x2 w = tr[64 * j]; u32x2 w2 = {0u, 0u}; if (npart == 1) w2 = tr2[64 * j]; t[j] = (f32x4){bflo(w.x) + bflo(w2.x), bfhi(w.x) + bfhi(w2.x), bflo(w.y) + bflo(w2.y), bfhi(w.y) + bfhi(w2.y)}; }
    s += (t[j].x * t[j].x + t[j].y * t[j].y) + (t[j].z * t[j].z + t[j].w * t[j].w); }
#pragma unroll
  for (int j = 0; j < 8; ++j) { if (XINB) { const u32x2 w = ((const u32x2*)xin + lane)[64 * j]; x[j] = (f32x4){bflo(w.x), bfhi(w.x), bflo(w.y), bfhi(w.y)}; } else x[j] = ((const f32x4*)xin + lane)[64 * j]; }
  const float rstd = rsqrtf(wave_sum(s) * (1.f / DM) + EPS);
  float s2 = 0.f;
#pragma unroll
  for (int j = 0; j < 8; ++j) { const f32x4 gg = gr[64 * j]; x[j] = x[j] + t[j] * rstd * gg; s2 += (x[j].x * x[j].x + x[j].y * x[j].y) + (x[j].z * x[j].z + x[j].w * x[j].w); }
  asm volatile("s_waitcnt vmcnt(0)" ::: "memory");
#pragma unroll
  for (int j = 0; j < 8; ++j) { if (XOUTB) { u32x2 w; w.x = cvtpk(x[j].x, x[j].y); w.y = cvtpk(x[j].z, x[j].w); ((u32x2*)xout + lane)[64 * j] = w; } else ((f32x4*)xout + lane)[64 * j] = x[j]; }
  if (rstd_out) { const float rstd2 = rsqrtf(wave_sum(s2) * (1.f / DM) + EPS); if (lane == 0) *rstd_out = rstd2; }
}
DI bf16* xb_row(float* outp, int m) { return (bf16*)((char*)outp + (size_t)m * 8192 + 4096); }
DI void row_mla(const bf16* d, int row, const float* qn, const float* kvn, unsigned char* ws, float* outp, int lane) {
  f32x4 a[2], c[2]; float sa = 0.f, sc = 0.f;
#pragma unroll
  for (int j = 0; j < 2; ++j) { const u32x2 wa = *(const u32x2*)(d + 4 * lane + 256 * j), wc = *(const u32x2*)(d + 512 + 4 * lane + 256 * j);
    a[j] = (f32x4){bflo(wa.x), bfhi(wa.x), bflo(wa.y), bfhi(wa.y)}; c[j] = (f32x4){bflo(wc.x), bfhi(wc.x), bflo(wc.y), bfhi(wc.y)};
    sa += (a[j].x * a[j].x + a[j].y * a[j].y) + (a[j].z * a[j].z + a[j].w * a[j].w); sc += (c[j].x * c[j].x + c[j].y * c[j].y) + (c[j].z * c[j].z + c[j].w * c[j].w); }
  const float ra = rsqrtf(wave_sum(sa) * (1.f / 512.f) + EPS), rc = rsqrtf(wave_sum(sc) * (1.f / 512.f) + EPS);
  bf16* cq = (bf16*)(ws + A_CQ) + (size_t)row * 512;
  bf16* ckv; bf16* kr; float* fckv; float* fkr;
  if (row < NPR) { ckv = (bf16*)(ws + A_CKVP) + (size_t)row * 512; kr = (bf16*)(ws + A_KRP) + (size_t)row * 64; fckv = outp + O_CKVP + (size_t)row * 512; fkr = outp + O_KRP + (size_t)row * 64; }
  else { const int rs = row - NPR, b = rs >> 6, i = rs & 63; const size_t r2 = (size_t)b * 2112 + 2048 + i;
    ckv = (bf16*)(ws + A_CKVS) + r2 * 512; kr = (bf16*)(ws + A_KRS) + r2 * 64; fckv = outp + O_CKVS + (size_t)rs * 512; fkr = outp + O_KRS + (size_t)rs * 64; }
#pragma unroll
  for (int j = 0; j < 2; ++j) {
    const f32x4 g1 = *(const f32x4*)(qn + 4 * lane + 256 * j), g2 = *(const f32x4*)(kvn + 4 * lane + 256 * j);
    const f32x4 q = a[j] * ra * g1, k = c[j] * rc * g2;
    u32x2 w; w.x = cvtpk(q.x, q.y); w.y = cvtpk(q.z, q.w); *(u32x2*)(cq + 4 * lane + 256 * j) = w;
    w.x = cvtpk(k.x, k.y); w.y = cvtpk(k.z, k.w); *(u32x2*)(ckv + 4 * lane + 256 * j) = w;
    *(f32x4*)(fckv + 4 * lane + 256 * j) = k;
  }
  if (lane < 32) {
    const float x1 = __uint_as_float((unsigned)d[1024 + lane] << 16), x2 = __uint_as_float((unsigned)d[1056 + lane] << 16);
    const float pos = (float)(row < NPR ? (row & 4095) : PAST + ((row - NPR) & 63));
    const float inv = exp2f(-(float)lane * 0.41524101186092029f);
    float sn, cs; sincos_cw(pos * inv, sn, cs);
    const float o1 = x1 * cs - x2 * sn, o2 = x2 * cs + x1 * sn;
    fkr[lane] = o1; fkr[32 + lane] = o2;
    *(unsigned*)(kr + 2 * lane) = cvtpk(o1, o2);
  }
}

DI unsigned f2bf(float f) { unsigned u = __builtin_bit_cast(unsigned, f); return (u + 0x7fffu + ((u >> 16) & 1u)) >> 16; }
DI unsigned pk2(float lo, float hi) { return f2bf(lo) | (f2bf(hi) << 16); }
template <int RMAP> DI void transpose_item(const float* W, int K, int N, bf16* WT, int row_off, LAS float* scr, int item, int lane, const float* gk = nullptr) {
  const int nblk = N / 64, kb = item / nblk, nb = item % nblk, k0 = 64 * kb, n0 = 64 * nb;
  const int lr = lane >> 4, lc = (lane & 15) * 4;
  f32x4 v[16];
#pragma unroll
  for (int i = 0; i < 16; ++i) v[i] = *(const f32x4*)(W + (size_t)(k0 + 4 * i + lr) * N + n0 + lc);
#pragma unroll
  for (int i = 0; i < 16; ++i) { LAS float* d = scr + (4 * i + lr) * 65 + lc; d[0] = v[i].x; d[1] = v[i].y; d[2] = v[i].z; d[3] = v[i].w; }
  asm volatile("s_waitcnt lgkmcnt(0)" ::: "memory");
  const int c = lane & 7;
  f32x4 ga = {1.f, 1.f, 1.f, 1.f}, gb = ga; if (gk) { ga = *(const f32x4*)(gk + k0 + 8 * c); gb = *(const f32x4*)(gk + k0 + 8 * c + 4); }
#pragma unroll
  for (int j = 0; j < 8; ++j) { const int n = (lane >> 3) + 8 * j; const LAS float* s = scr + (8 * c) * 65 + n;
    u32x4 o; o.x = cvtpk(s[0 * 65] * ga.x, s[1 * 65] * ga.y); o.y = cvtpk(s[2 * 65] * ga.z, s[3 * 65] * ga.w); o.z = cvtpk(s[4 * 65] * gb.x, s[5 * 65] * gb.y); o.w = cvtpk(s[6 * 65] * gb.z, s[7 * 65] * gb.w);
    int orow = row_off + n0 + n;
    if (RMAP == 1) { const int nn = n0 + n, h = nn / 192, e = nn % 192; if (e < 128) orow = h * 128 + e; else { const int jj = e - 128; orow = 2048 + h * 64 + (jj < 32 ? 2 * jj : 2 * (jj - 32) + 1); } }
    *(u32x4*)(WT + (size_t)orow * K + k0 + 8 * c) = o; }
  asm volatile("s_waitcnt lgkmcnt(0)" ::: "memory");
}
namespace att {
constexpr int SHM_V = 16384, SHM_K = 64 * 272, SHM_KR = 64 * 144;
constexpr int OFF_V = 0, OFF_K = 2 * SHM_V, OFF_KR = OFF_K + 2 * SHM_K, OFF_WS = OFF_KR + 2 * SHM_KR, OFF_BIAS = OFF_WS + 8 * 64 * 4, LDS_END = OFF_BIAS + 640 * 4;
#define KSWZ(row, colB) ((row) * 272 + (colB))
#define KRSWZ(row, colB) ((row) * 144 + (colB))
#define SBAR() __builtin_amdgcn_sched_barrier(0)
DI int crow(int r, int hi) { return (r & 3) + 8 * (r >> 2) + 4 * hi; }
struct Unit {
  const bf16* Q; const bf16* Qr; int ldq;
  const bf16* K; const bf16* V; const bf16* KR; int ldk;
  bf16* O; int ldo;
  int nt, nact, thi0, tlo0, qrel0;
  const float* bias;
};
template <bool BAND> DI void partialSM(f32x16& p0, f32x16& p1, float& m_reg, float& mn, float& alpha, bool masked, const LAS float* tb, float C) {
  if (masked) {
#pragma unroll
    for (int r = 0; r < 16; ++r) { p0[r] = -1e30f; p1[r] = -1e30f; }
  } else if (BAND) {
#pragma unroll
    for (int r = 0; r < 16; ++r) { const int ko = (r & 3) + 8 * (r >> 2); p0[r] = fmaf(p0[r], C, tb[ko]); }
    SBAR();
#pragma unroll
    for (int r = 0; r < 16; ++r) { const int ko = (r & 3) + 8 * (r >> 2); p1[r] = fmaf(p1[r], C, tb[ko + 32]); }
  }
  const float CC = BAND ? 1.f : C;
  const float THRP = 11.5f / CC;
  float pmax = p0[0];
#pragma unroll
  for (int r = 1; r < 16; ++r) pmax = fmaxf(pmax, p0[r]);
#pragma unroll
  for (int r = 0; r < 16; ++r) pmax = fmaxf(pmax, p1[r]);
  { auto rr = __builtin_amdgcn_permlane32_swap(__float_as_uint(pmax), __float_as_uint(pmax), false, false);
    pmax = fmaxf(__uint_as_float(rr[0]), __uint_as_float(rr[1])); }
  if (__builtin_expect(__all(pmax - m_reg <= THRP), 1)) { mn = m_reg; alpha = 1.f; }
  else { mn = fmaxf(m_reg, pmax); alpha = __builtin_amdgcn_exp2f((m_reg - mn) * CC); m_reg = mn; }
  const float mnC = -mn * CC;
#pragma unroll
  for (int r = 0; r < 16; ++r) p0[r] = fmaf(p0[r], CC, mnC);
#pragma unroll
  for (int r = 0; r < 16; ++r) p1[r] = fmaf(p1[r], CC, mnC);
#pragma unroll
  for (int r = 0; r < 16; ++r) p0[r] = __builtin_amdgcn_exp2f(p0[r]);
}
DI void finishSM(f32x16& p0, f32x16& p1, float alpha, float& l_reg, bf16x8& pa0, bf16x8& pa1, bf16x8& pa2, bf16x8& pa3) {
#pragma unroll
  for (int r = 0; r < 16; ++r) p1[r] = __builtin_amdgcn_exp2f(p1[r]);
  float ps = 0;
#pragma unroll
  for (int r = 0; r < 16; ++r) ps += p0[r];
#pragma unroll
  for (int r = 0; r < 16; ++r) ps += p1[r];
  { auto rr = __builtin_amdgcn_permlane32_swap(__float_as_uint(ps), __float_as_uint(ps), false, false);
    ps = __uint_as_float(rr[0]) + __uint_as_float(rr[1]); }
  l_reg = l_reg * alpha + ps;
#define PK4(P, BASE, OUT) do { unsigned a0 = cvtpk(P[BASE + 0], P[BASE + 1]), a1 = cvtpk(P[BASE + 2], P[BASE + 3]);   \
    unsigned b0 = cvtpk(P[BASE + 4], P[BASE + 5]), b1 = cvtpk(P[BASE + 6], P[BASE + 7]);                              \
    auto r0 = __builtin_amdgcn_permlane32_swap(a0, b0, false, false); auto r1 = __builtin_amdgcn_permlane32_swap(a1, b1, false, false); \
    u32x4 w = {r0[0], r1[0], r0[1], r1[1]}; OUT = __builtin_bit_cast(bf16x8, w); } while (0)
  PK4(p0, 0, pa0); PK4(p0, 8, pa1); PK4(p1, 0, pa2); PK4(p1, 8, pa3);
#undef PK4
}
template <int NQ> DI void qkt(f32x16& p0, f32x16& p1, const LAS char* Ks, const LAS char* KRs, const bf16x8* qr, int r32, int hi) {
  p0 = f32x16{}; p1 = f32x16{};
#pragma unroll
  for (int d0 = 0; d0 < 8; ++d0) { const int cb = (d0 * 16 + hi * 8) * 2;
    const bf16x8 b0 = *(const LAS bf16x8*)(Ks + KSWZ(r32, cb));
    const bf16x8 b1 = *(const LAS bf16x8*)(Ks + KSWZ(32 + r32, cb));
    p0 = __builtin_amdgcn_mfma_f32_32x32x16_bf16(b0, qr[d0], p0, 0, 0, 0);
    p1 = __builtin_amdgcn_mfma_f32_32x32x16_bf16(b1, qr[d0], p1, 0, 0, 0); }
  if (NQ == 12) {
#pragma unroll
    for (int d0 = 0; d0 < 4; ++d0) { const int cb = (d0 * 16 + hi * 8) * 2;
      const bf16x8 b0 = *(const LAS bf16x8*)(KRs + KRSWZ(r32, cb));
      const bf16x8 b1 = *(const LAS bf16x8*)(KRs + KRSWZ(32 + r32, cb));
      p0 = __builtin_amdgcn_mfma_f32_32x32x16_bf16(b0, qr[8 + d0], p0, 0, 0, 0);
      p1 = __builtin_amdgcn_mfma_f32_32x32x16_bf16(b1, qr[8 + d0], p1, 0, 0, 0); }
  }
}
DI int v_st(int k, int c) { const int kk = (k & ~0xC) | ((k & 4) << 1) | ((k & 8) >> 1); return ((kk >> 3) * 4 + (c >> 5)) * 512 + ((kk & 7) * 32 + (c & 31)) * 2; }
DI int v_rd_base(int lane) { return ((lane & 3) << 3) | (((lane >> 2) & 3) << 6) | (((lane >> 4) & 1) << 5) | (((lane >> 5) & 1) << 8); }
constexpr int v_rd_off(int d0, int ks, int half) { return d0 * 512 + ks * 4096 + half * 2048; }
template <int OFF> DI s16x4 tr_read(int vb) { s16x4 r; asm volatile("ds_read_b64_tr_b16 %0, %1 offset:%2" : "=&v"(r) : "v"(vb), "i"(OFF) : "memory"); return r; }
template <int D0> DI void pv_one(f32x16& od, int vb, bf16x8 pa0, bf16x8 pa1, bf16x8 pa2, bf16x8 pa3) {
  const s16x4 l0 = tr_read<v_rd_off(D0, 0, 0)>(vb), h0 = tr_read<v_rd_off(D0, 0, 1)>(vb), l1 = tr_read<v_rd_off(D0, 1, 0)>(vb), h1 = tr_read<v_rd_off(D0, 1, 1)>(vb);
  const s16x4 l2 = tr_read<v_rd_off(D0, 2, 0)>(vb), h2 = tr_read<v_rd_off(D0, 2, 1)>(vb), l3 = tr_read<v_rd_off(D0, 3, 0)>(vb), h3 = tr_read<v_rd_off(D0, 3, 1)>(vb);
  asm volatile("s_waitcnt lgkmcnt(0)" ::: "memory"); SBAR();
#define PK(L, H) (bf16x8){L[0], L[1], L[2], L[3], H[0], H[1], H[2], H[3]}
  od = __builtin_amdgcn_mfma_f32_32x32x16_bf16(pa0, PK(l0, h0), od, 0, 0, 0);
  od = __builtin_amdgcn_mfma_f32_32x32x16_bf16(pa1, PK(l1, h1), od, 0, 0, 0);
  od = __builtin_amdgcn_mfma_f32_32x32x16_bf16(pa2, PK(l2, h2), od, 0, 0, 0);
  od = __builtin_amdgcn_mfma_f32_32x32x16_bf16(pa3, PK(l3, h3), od, 0, 0, 0);
#undef PK
}
DI void pv_d0(f32x16* o, int vb, bf16x8 pa0, bf16x8 pa1, bf16x8 pa2, bf16x8 pa3) {
  pv_one<0>(o[0], vb, pa0, pa1, pa2, pa3); pv_one<1>(o[1], vb, pa0, pa1, pa2, pa3); pv_one<2>(o[2], vb, pa0, pa1, pa2, pa3); pv_one<3>(o[3], vb, pa0, pa1, pa2, pa3);
}

template <bool BAND, int SD, bool ACT> DI void attn_unit_(const Unit& U, LAS char* lds, float C) {
  constexpr int NQ = BAND ? 8 : 12;
  int tid = threadIdx.x; asm volatile("" : "+v"(tid)); const int wid = __builtin_amdgcn_readfirstlane(tid >> 6), lane = tid & 63, r32 = lane & 31, hi = lane >> 5;
  LAS char* V_lds = lds + OFF_V; LAS char* K_lds = lds + OFF_K; LAS char* KR_lds = lds + OFF_KR;
  LAS float* wsf = (LAS float*)(lds + OFF_WS) + wid * 64; LAS float* li_l = wsf; LAS float* al_l = wsf + 32;
  LAS float* T3 = (LAS float*)(lds + OFF_BIAS);
  const int wq = wid & (U.nact - 1);
  const int cw = wid >> 1; const int t_hi = U.thi0 + cw; const int t_lo = (U.tlo0 + cw) > 0 ? (U.tlo0 + cw) : 0;
  float m_reg = -1e30f, l_reg = 0; f32x16 o[4] = {}; bf16x8 qr[NQ];
  if (ACT) {
    const bf16* Qw = U.Q + (size_t)(wq * 32 + r32) * U.ldq + hi * 8;
#pragma unroll
    for (int d0 = 0; d0 < 8; ++d0) qr[d0] = *(const bf16x8*)(Qw + d0 * 16);
    if (!BAND) { const bf16* Qw2 = U.Qr + (size_t)(wq * 32 + r32) * U.ldq + hi * 8;
#pragma unroll
      for (int d0 = 0; d0 < 4; ++d0) qr[(NQ == 12 ? 8 : 0) + d0] = *(const bf16x8*)(Qw2 + d0 * 16); }
  }
  if (BAND) { for (int j = tid; j < 640; j += 512) { int rel = 575 - j; rel = rel > 256 ? 256 : rel; T3[j] = U.bias[rel + 256] * LOG2E; } }
  const int sr = tid >> 4, sc = (tid & 15) * 8, vst0 = v_st(sr, sc), vst1 = v_st(32 + sr, sc);
  const int krr = tid >> 3, krc = (tid & 7) * 8;
  const int vb0 = (int)(uintptr_t)V_lds + v_rd_base(lane);
  const int jb0 = 575 - U.qrel0 - 32 * wq - r32 + 4 * hi;
  struct { bf16x8 vs0, vs1, ks0, ks1, kr; } sr_[SD];
  const int ntr = U.nt, NT = (U.nt + 1) & ~1;
  const unsigned vo0 = (unsigned)(sr * U.ldk + sc) * 2u, vo1 = (unsigned)((32 + sr) * U.ldk + sc) * 2u, vokr = (unsigned)(krr * 64 + krc) * 2u;
  const size_t tstep = (size_t)64 * U.ldk * 2;
#define SLOAD(i, t) do { const int tt_ = (t) < ntr ? (t) : ntr - 1; const char* kt_ = (const char*)U.K + tt_ * tstep; const char* vt_ = (const char*)U.V + tt_ * tstep;  \
    sr_[i].vs0 = *(const bf16x8*)(vt_ + vo0); sr_[i].vs1 = *(const bf16x8*)(vt_ + vo1);         \
    sr_[i].ks0 = *(const bf16x8*)(kt_ + vo0); sr_[i].ks1 = *(const bf16x8*)(kt_ + vo1);         \
    if (!BAND) sr_[i].kr = *(const bf16x8*)((const char*)U.KR + (size_t)tt_ * 8192 + vokr); } while (0)
#define SWRITE(b, i) do { *(LAS bf16x8*)(V_lds + (b) * SHM_V + vst0) = sr_[i].vs0; *(LAS bf16x8*)(V_lds + (b) * SHM_V + vst1) = sr_[i].vs1; \
    const int kc_ = sc * 2; *(LAS bf16x8*)(K_lds + (b) * SHM_K + KSWZ(sr, kc_)) = sr_[i].ks0; *(LAS bf16x8*)(K_lds + (b) * SHM_K + KSWZ(32 + sr, kc_)) = sr_[i].ks1; \
    if (!BAND) *(LAS bf16x8*)(KR_lds + (b) * SHM_KR + KRSWZ(krr, krc * 2)) = sr_[i].kr; } while (0)
#define SWAIT() do { if (SD == 2) asm volatile("s_waitcnt vmcnt(%0)" ::"n"(BAND ? 4 : 5) : "memory"); else asm volatile("s_waitcnt vmcnt(0)" ::: "memory"); } while (0)
#define RESC(a) do { if (__any((a) < 1.f)) { if (hi == 0) al_l[r32] = (a); asm volatile("s_waitcnt lgkmcnt(0)" ::: "memory"); \
    _Pragma("unroll") for (int d = 0; d < 4; ++d) _Pragma("unroll") for (int r = 0; r < 16; ++r) o[d][r] *= al_l[crow(r, hi)]; } } while (0)
#define MASKED(t) ((t) < t_lo || (t) > t_hi)
  f32x16 pA0, pA1, pB0, pB1; float mnA, mnB, alA = 1.f, alB = 1.f; bf16x8 pa0, pa1, pa2, pa3;
  { u32x4 zz = {0u, 0u, 0u, 0u}; asm volatile("" : "+v"(zz)); pa0 = pa1 = pa2 = pa3 = __builtin_bit_cast(bf16x8, zz); }
  constexpr int SE = 0, SO = SD - 1;
  SLOAD(SE, 0); if (SD == 2) SLOAD(SO, 1);
  if (SD == 2) asm volatile("s_waitcnt vmcnt(%0)" ::"n"(BAND ? 4 : 5) : "memory"); else asm volatile("s_waitcnt vmcnt(0)" ::: "memory");
  SWRITE(0, SE);
  if (SD == 2) { if (2 < NT) SLOAD(SE, 2); } else SLOAD(SO, 1);
  __syncthreads();
  if (ACT) { qkt<NQ>(pA0, pA1, K_lds, KR_lds, qr, r32, hi); partialSM<BAND>(pA0, pA1, m_reg, mnA, alA, MASKED(0), T3 + jb0, C); }
  SWAIT(); SWRITE(1, SO); __syncthreads();
  for (int j = 1; j + 1 < NT; j += 2) {
    SBAR();
    if (ACT) { qkt<NQ>(pB0, pB1, K_lds + SHM_K, KR_lds + SHM_KR, qr, r32, hi); finishSM(pA0, pA1, alA, l_reg, pa0, pa1, pa2, pa3); }
    SBAR();
    SLOAD(SO, j + SD); SBAR();
    if (ACT) { pv_d0(o, vb0, pa0, pa1, pa2, pa3); partialSM<BAND>(pB0, pB1, m_reg, mnB, alB, MASKED(j), T3 + jb0 + 64 * j, C); }
    __syncthreads(); SWAIT(); SWRITE(0, SE);
    if (ACT) RESC(alB);
    __syncthreads();
    SBAR();
    if (ACT) { qkt<NQ>(pA0, pA1, K_lds, KR_lds, qr, r32, hi); finishSM(pB0, pB1, alB, l_reg, pa0, pa1, pa2, pa3); }
    SBAR();
    if (SD == 1 || j + 3 < NT) SLOAD(SE, j + 1 + SD); SBAR();
    if (ACT) { pv_d0(o, vb0 + SHM_V, pa0, pa1, pa2, pa3); partialSM<BAND>(pA0, pA1, m_reg, mnA, alA, MASKED(j + 1), T3 + jb0 + 64 * (j + 1), C); }
    __syncthreads(); SWAIT(); SWRITE(1, SO);
    if (ACT) RESC(alA);
    __syncthreads();
  }
  SBAR();
  if (ACT) {
    qkt<NQ>(pB0, pB1, K_lds + SHM_K, KR_lds + SHM_KR, qr, r32, hi);
    finishSM(pA0, pA1, alA, l_reg, pa0, pa1, pa2, pa3); SBAR();
    pv_d0(o, vb0, pa0, pa1, pa2, pa3); partialSM<BAND>(pB0, pB1, m_reg, mnB, alB, MASKED(NT - 1), T3 + jb0 + 64 * (NT - 1), C);
  }
  __syncthreads();
  if (ACT) {
    RESC(alB);
    finishSM(pB0, pB1, alB, l_reg, pa0, pa1, pa2, pa3); SBAR();
    pv_d0(o, vb0 + SHM_V, pa0, pa1, pa2, pa3);
    if (hi == 0) li_l[r32] = l_reg; asm volatile("s_waitcnt lgkmcnt(0)" ::: "memory");
    float rli[16];
#pragma unroll
    for (int r = 0; r < 16; ++r) rli[r] = __builtin_amdgcn_rcpf(li_l[crow(r, hi)]);
    LAS char* stg = lds + (wid < 2 ? OFF_V + wid * 8192 : OFF_K + (wid - 2) * 8192);
#pragma unroll
    for (int r = 0; r < 16; ++r) { const int orow = crow(r, hi);
#pragma unroll
      for (int d0 = 0; d0 < 4; ++d0) *(LAS bf16*)(stg + orow * 256 + (d0 * 32 + r32) * 2) = (bf16)(cvtpk(o[d0][r] * rli[r], 0.f) & 0xffffu); }
    asm volatile("s_waitcnt lgkmcnt(0)" ::: "memory");
    bf16* Ow = U.O + (size_t)(wid * 32) * U.ldo;
#pragma unroll
    for (int i = 0; i < 8; ++i) { const int row = i * 4 + (lane >> 4), ch = lane & 15; const u32x4 v = *(const LAS u32x4*)(stg + row * 256 + ch * 16); *(u32x4*)(Ow + (size_t)row * U.ldo + ch * 8) = v; }
  }
  asm volatile("s_waitcnt vmcnt(0) lgkmcnt(0)" ::: "memory");
  __syncthreads();
#undef SLOAD
#undef SWRITE
#undef SWAIT
#undef RESC
#undef MASKED
}
template <bool BAND, int SD> DI void attn_unit(const Unit& U, LAS char* lds, float C) {
  const int wid = __builtin_amdgcn_readfirstlane((int)threadIdx.x >> 6);
  if (wid < U.nact) attn_unit_<BAND, SD, true>(U, lds, C); else attn_unit_<BAND, SD, false>(U, lds, C);
}
}
#define XB_TMO      128
#define XB_XCNT(j)  (256  + 64 * (j))
#define XB_XSUB(j)  (1280 + 64 * (j))
#define XB_XGEN(j)  (2304 + 64 * (j))
#define XB_TOP      3328
#define XB_TOPGEN   3392
#define XCD_BAR_WORDS 3456
#define XB_SPIN_CAP (1u << 18)

__device__ __forceinline__ unsigned xb_ld(unsigned* p)              { return __hip_atomic_load(p, __ATOMIC_RELAXED, __HIP_MEMORY_SCOPE_AGENT); }
__device__ __forceinline__ unsigned xb_add(unsigned* p, unsigned v) { return __hip_atomic_fetch_add(p, v, __ATOMIC_RELAXED, __HIP_MEMORY_SCOPE_AGENT); }
__device__ __forceinline__ unsigned xb_xcc_id() { return (unsigned)__builtin_amdgcn_s_getreg((3 << 11) | 20) & 0xFu; }
#define XB_SPIN(cond, bar) do { unsigned _sp = 0; while (cond) { __builtin_amdgcn_s_sleep(1); \
    if ((++_sp & 255u) == 0u) { if (xb_ld(&(bar)[XB_TMO])) break; if (_sp > XB_SPIN_CAP) { atomicAdd(&(bar)[XB_TMO], 1u); break; } } } } while (0)

struct XcdBarrier {
    unsigned* bar; unsigned x;
    volatile LAS unsigned* st;
};

__device__ __forceinline__ XcdBarrier xcd_barrier_post(unsigned* bar, volatile LAS unsigned* st) {
    XcdBarrier b; b.bar = bar; b.x = xb_xcc_id(); b.st = st;
    if (threadIdx.x == 0) (void)xb_add(&bar[XB_XCNT(b.x)], 1u);
    return b;
}
__device__ __forceinline__ void xcd_barrier_complete(unsigned* bar, unsigned x, unsigned& nloc, unsigned& nx) {
    const unsigned G = gridDim.x * gridDim.y * gridDim.z;
    unsigned sum, cnt, mine, sp = 0u;
    for (;;) {
        sum = 0u; cnt = 0u; mine = 0u;
#pragma unroll
        for (unsigned j = 0; j < 16; ++j) { const unsigned c = xb_ld(&bar[XB_XCNT(j)]); sum += c; cnt += (c > 0u) ? 1u : 0u; mine = (j == x) ? c : mine; }
        if (sum == G) break;
        __builtin_amdgcn_s_sleep(1);
        if ((++sp & 255u) == 0u) { if (xb_ld(&bar[XB_TMO])) break; if (sp > XB_SPIN_CAP) { atomicAdd(&bar[XB_TMO], 1u); break; } }
    }
    nloc = mine > 0u ? mine : 1u; nx = cnt > 0u ? cnt : 1u;
}

__device__ __forceinline__ void xcd_barrier(const XcdBarrier& b) {
    asm volatile("s_waitcnt vmcnt(0)" ::: "memory");
    __syncthreads();
    if (threadIdx.x == 0) {
        unsigned* bar = b.bar;
        __builtin_amdgcn_s_waitcnt(0);
        unsigned nloc = b.st[0], nx = b.st[1];
        if (nloc == 0u) { xcd_barrier_complete(bar, b.x, nloc, nx); b.st[0] = nloc; b.st[1] = nx; }
        const unsigned old = xb_add(&bar[XB_XSUB(b.x)], 1u);
        const unsigned gen = old / nloc;
        if (old + 1u == (gen + 1u) * nloc) {
            __builtin_amdgcn_fence(__ATOMIC_RELEASE, "agent");
            asm volatile("s_waitcnt vmcnt(0)" ::: "memory");
            const unsigned og = xb_add(&bar[XB_TOP], 1u);
            const unsigned tg = og / nx;
            if (og + 1u == (tg + 1u) * nx) xb_add(&bar[XB_TOPGEN], 1u);
            else XB_SPIN(xb_ld(&bar[XB_TOPGEN]) == tg, bar);
            __builtin_amdgcn_fence(__ATOMIC_ACQUIRE, "agent");
            xb_add(&bar[XB_XGEN(b.x)], 1u);
            asm volatile("s_waitcnt vmcnt(0)" ::: "memory");
        } else {
            XB_SPIN(xb_ld(&bar[XB_XGEN(b.x)]) == gen, bar);
            __builtin_amdgcn_fence(__ATOMIC_ACQUIRE, "agent");
            asm volatile("s_waitcnt vmcnt(0)" ::: "memory");
        }
    }
    __syncthreads();
}

#ifndef PROBE_PH
#define PROBE_PH 0
#endif
#ifndef PROBE_REP
#define PROBE_REP 0
#endif
#ifndef PROBE_SYNC
#define PROBE_SYNC 0
#endif
#ifndef BAND_SD
#define BAND_SD 2
#endif
#ifndef MLA_SD
#define MLA_SD 1
#endif
constexpr int NSTEPS = 20;
struct Args { const float* in[23]; float* out; unsigned char* ws; int ph_lo, ph_hi; };
constexpr int LDS_BYTES = 133120 + 1024;

typedef const __attribute__((address_space(4))) Args CArgs;
DI const float* xin_row(CArgs& a, int row) { return row < NPR ? a.in[0] + (size_t)row * DM : a.in[1] + (size_t)(row - NPR) * DM; }

DI bool get_gemm(int ph, bool tail8, CArgs& a, const bf16*& A, int& lda, const bf16*& Bt, int& M, int& N, int& K, EpiMode& E) {
  unsigned char* ws = a.ws;
  E.mode = EM_BF16; E.O = nullptr; E.O2 = nullptr; E.ldc = 0; E.F = nullptr; E.outp = a.out; E.ws = ws; E.rs = (const float*)(ws + A_RSTD); lda = 0;
  switch (ph) {
    case 1:  A = (const bf16*)((const char*)a.out + 4096); lda = 4096; Bt = (const bf16*)(ws + W_QKV); M = MT; N = 6144; K = 2048; E.mode = EM_QKV; return true;
    case 3:  A = (const bf16*)(ws + A_O0);   Bt = (const bf16*)(ws + W_AO);  M = MT; N = 2048; K = 2048; E.O = (bf16*)(ws + A_T); E.ldc = 2048; if (tail8) { E.mode = EM_TAIL; E.O2 = (bf16*)(ws + A_Q0); } return true;
    case 5:  A = (const bf16*)((const char*)a.out + 4096); lda = 4096; Bt = (const bf16*)(ws + W_F1);  M = MT; N = 8192; K = 2048; E.mode = EM_RELU2; E.O = (bf16*)(ws + A_HID); E.ldc = 8192; return true;
    case 6:  A = (const bf16*)(ws + A_HID);  Bt = (const bf16*)(ws + W_F2);  M = MT; N = 2048; K = 8192; E.mode = tail8 ? EM_TAIL : EM_SPLIT; E.O = (bf16*)(ws + A_T); E.O2 = (bf16*)(ws + (tail8 ? A_PF : A_H)); E.ldc = 2048; return true;
    case 8:  A = (const bf16*)((const char*)a.out + 4096); lda = 4096; Bt = (const bf16*)(ws + W_D);   M = MT; N = 1280; K = 2048; E.mode = EM_F32; E.F = (float*)(ws + A_DQ); E.ldc = 1280; return true;
    case 10: A = (const bf16*)(ws + A_CQ);   Bt = (const bf16*)(ws + W_UQ);  M = MT; N = 3072; K = 512; E.mode = EM_QROPE; E.O = (bf16*)(ws + A_QM); E.ldc = 3072; return true;
    case 11: A = (const bf16*)(ws + A_CKVP); Bt = (const bf16*)(ws + W_UKV); M = NPR; N = 4096; K = 512; E.O = (bf16*)(ws + A_KNV); E.ldc = 4096; return true;
    case 13: A = (const bf16*)(ws + A_CKVS); Bt = (const bf16*)(ws + W_UKV); M = 33792; N = 4096; K = 512; E.O = (bf16*)(ws + A_KNV); E.ldc = 4096; return true;
    case 15: A = (const bf16*)(ws + A_O1);   Bt = (const bf16*)(ws + W_MO);  M = MT; N = 2048; K = 2048; E.O = (bf16*)(ws + A_T); E.ldc = 2048; if (tail8) { E.mode = EM_TAIL; E.O2 = (bf16*)(ws + A_QM); } return true;
    case 17: A = (const bf16*)((const char*)a.out + 4096); lda = 4096; Bt = (const bf16*)(ws + W_F1);  M = MT; N = 8192; K = 2048; E.mode = EM_RELU2; E.O = (bf16*)(ws + A_HID); E.ldc = 8192; return true;
    case 18: A = (const bf16*)(ws + A_HID);  Bt = (const bf16*)(ws + W_F2);  M = MT; N = 2048; K = 8192; E.mode = tail8 ? EM_TAIL : EM_SPLIT; E.O = (bf16*)(ws + A_T); E.O2 = (bf16*)(ws + (tail8 ? A_PF : A_H)); E.ldc = 2048; return true;
    default: return false;
  }
}

__global__ void __launch_bounds__(512) fwd_mega(Args a_) {
  extern __shared__ __attribute__((aligned(16))) unsigned char lds_raw[];
  LAS unsigned char* lds = (LAS unsigned char*)lds_raw;
  cg::grid_group grid = cg::this_grid();
  if (threadIdx.x < 2) ((volatile LAS unsigned*)(lds + 133120))[threadIdx.x] = 0u;
  __syncthreads();
  const XcdBarrier xbar = xcd_barrier_post((unsigned*)(a_.ws + A_BAR), (volatile LAS unsigned*)(lds + 133120));
  for (int it_ = a_.ph_lo; it_ < a_.ph_hi; ++it_) {
    const int ph = it_ <= PROBE_PH ? it_ : (it_ <= PROBE_PH + PROBE_REP ? PROBE_PH : it_ - PROBE_REP);
    const __attribute__((address_space(4))) char* kp_ = (const __attribute__((address_space(4))) char*)__builtin_amdgcn_kernarg_segment_ptr();
    asm volatile("" : "+s"(kp_));
    CArgs& a = *(CArgs*)kp_;
    int tid = threadIdx.x; asm volatile("" : "+v"(tid));
    const int lane = tid & 63, wave = __builtin_amdgcn_readfirstlane(tid >> 6);
    const int G = gridDim.x, gw = blockIdx.x * 8 + wave, NGW = G * 8;
    const size_t gt = (size_t)blockIdx.x * 512 + tid, NGT = (size_t)G * 512;
    unsigned char* ws = a.ws; float* outp = a.out;
    const bf16* gA; const bf16* gB; int gM, gN, gK; EpiMode E;
    const bool tail8 = (G == 256);
    int gLda;
    if (get_gemm(ph, tail8, a, gA, gLda, gB, gM, gN, gK, E)) {
#ifndef NO_GEMM
      run_gemm(lds, gA, gLda ? gLda : gK, gB, gM, gN, gK, E);
#endif
      if (ph == 1 || ph == 5 || ph == 8 || ph == 17) {
        const int nwg_ = (gM / 256) * (gN / 256), rem_ = nwg_ % G;
        int li_ = (int)blockIdx.x, nl_ = G;
        if (rem_ != 0) { li_ = (int)blockIdx.x - rem_; nl_ = li_ >= 0 ? G - rem_ : 0; }
        if (nl_ > 0) {
          LAS float* scr = (LAS float*)(lds + wave * 16640);
          const int w0 = li_ * 8 + wave, nw = nl_ * 8;
          if (ph == 1) {
            constexpr int I1 = 32 * 32, I2 = 32 * 8, I3 = 32 * 9, I4 = 8 * 48, I5 = 8 * 32, I6 = 8 * 32, I7 = 32 * 32, I8 = 32 * 128;
            constexpr int NIT = I1 + I2 + I3 + I4 + I5 + I6 + I7 + I8;
            for (int it = w0; it < NIT; it += nw) {
              int r = it;
              if (r < I1) { transpose_item<0>(a.in[11], 2048, 2048, (bf16*)(ws + W_AO), 0, scr, r, lane); continue; } r -= I1;
              if (r < I2) { transpose_item<0>(a.in[13], 2048, 512, (bf16*)(ws + W_D), 0, scr, r, lane, a.in[6] + DM); continue; } r -= I2;
              if (r < I3) { transpose_item<0>(a.in[16], 2048, 576, (bf16*)(ws + W_D), 512, scr, r, lane, a.in[6] + DM); continue; } r -= I3;
              if (r < I4) { transpose_item<1>(a.in[15], 512, 3072, (bf16*)(ws + W_UQ), 0, scr, r, lane); continue; } r -= I4;
              if (r < I5) { transpose_item<0>(a.in[18], 512, 2048, (bf16*)(ws + W_UKV), 0, scr, r, lane); continue; } r -= I5;
              if (r < I6) { transpose_item<0>(a.in[19], 512, 2048, (bf16*)(ws + W_UKV), 2048, scr, r, lane); continue; } r -= I6;
              if (r < I7) { transpose_item<0>(a.in[20], 2048, 2048, (bf16*)(ws + W_MO), 0, scr, r, lane); continue; } r -= I7;
              transpose_item<0>(a.in[21], 2048, 8192, (bf16*)(ws + W_F1), 0, scr, r, lane, a.in[8]);
            }
          } else if (ph == 5) {
            for (int it = w0; it < 128 * 32; it += nw) transpose_item<0>(a.in[22], 8192, 2048, (bf16*)(ws + W_F2), 0, scr, it, lane);
          } else if (ph == 8) {
            for (int it = w0; it < 32 * 128; it += nw) transpose_item<0>(a.in[21] + (size_t)2048 * 8192, 2048, 8192, (bf16*)(ws + W_F1), 0, scr, it, lane, a.in[8] + DM);
          } else {
            for (int it = w0; it < 128 * 32; it += nw) transpose_item<0>(a.in[22] + (size_t)2048 * 8192, 8192, 2048, (bf16*)(ws + W_F2), 0, scr, it, lane);
          }
        }
      }
    } else if (ph == 0 || ph == 7) {
      LAS float* scr = (LAS float*)(lds + wave * 16640);
      if (ph == 0) {
        for (int it = gw; it < 32 * 96; it += NGW) transpose_item<0>(a.in[10], 2048, 6144, (bf16*)(ws + W_QKV), 0, scr, it, lane, a.in[6]);
        { u32x4* z = (u32x4*)((bf16*)(ws + W_D) + (size_t)1088 * 2048); const size_t n16 = (size_t)192 * 2048 * 2 / 16;
          u32x4 zv = {0u, 0u, 0u, 0u}; asm volatile("" : "+v"(zv));
          for (size_t i = gt; i < n16; i += NGT) z[i] = zv; }
        { const size_t ng = (size_t)16 * 512 * 256;
#define CVT_A_LD(i, va, vb) const int isv##va = (i) >= ng; const size_t g##va = isv##va ? (i) - ng : (i); const float* s##va = a.in[isv##va ? 3 : 2] + g##va * 8; const f32x4 va = *(const f32x4*)s##va, vb = *(const f32x4*)(s##va + 4)
#define CVT_A_ST(va, vb) *(u32x4*)((bf16*)(ws + (isv##va ? A_VS : A_KS)) + (g##va / (512 * 256)) * 576 * 2048 + (g##va % (512 * 256)) * 8) = pack8(va, vb)
          size_t i = gt;
          for (; i + 3 * NGT < 2 * ng; i += 4 * NGT) { CVT_A_LD(i, p0, p1); CVT_A_LD(i + NGT, q0, q1); CVT_A_LD(i + 2 * NGT, r0, r1); CVT_A_LD(i + 3 * NGT, t0, t1);
            CVT_A_ST(p0, p1); CVT_A_ST(q0, q1); CVT_A_ST(r0, r1); CVT_A_ST(t0, t1); }
          for (; i < 2 * ng; i += NGT) { CVT_A_LD(i, p0, p1); CVT_A_ST(p0, p1); }
#undef CVT_A_LD
#undef CVT_A_ST
        }
        for (int m = gw; m < MT; m += NGW) row_x_prep(xin_row(a, m), xb_row(outp, m), (float*)(ws + A_RSTD) + m, lane);
      } else {
        for (int m = gw; m < MT; m += NGW)
          row_resid_norm<true, true>((const bf16*)(ws + A_T) + (size_t)m * DM, tail8 ? (const bf16*)(ws + A_PF) + (size_t)(m - NPR) * DM : (const bf16*)(ws + A_H) + (size_t)m * DM, tail8 ? (m < NPR ? 0 : 8) : 1, xb_row(outp, m), xb_row(outp, m), a.in[9], (float*)(ws + A_RSTD) + m, lane);
      }
    } else if (ph == 4) {
      for (int m = gw; m < MT; m += NGW)
        row_resid_norm<true, true>((const bf16*)(ws + A_T) + (size_t)m * DM, (const bf16*)(ws + A_Q0) + (size_t)(m - NPR) * DM, (tail8 && m >= NPR) ? 8 : 0, xb_row(outp, m), xb_row(outp, m), a.in[7], (float*)(ws + A_RSTD) + m, lane);
    } else if (ph == 16) {
      for (int m = gw; m < MT; m += NGW)
        row_resid_norm<true, true>((const bf16*)(ws + A_T) + (size_t)m * DM, (const bf16*)(ws + A_QM) + (size_t)(m - NPR) * DM, (tail8 && m >= NPR) ? 8 : 0, xb_row(outp, m), xb_row(outp, m), a.in[7] + DM, (float*)(ws + A_RSTD) + m, lane);
    } else if (ph == 19) {
      for (int m = gw; m < MT; m += NGW)
        row_resid_norm<true, false>((const bf16*)(ws + A_T) + (size_t)m * DM, tail8 ? (const bf16*)(ws + A_PF) + (size_t)(m - NPR) * DM : (const bf16*)(ws + A_H) + (size_t)m * DM, tail8 ? (m < NPR ? 0 : 8) : 1, xb_row(outp, m), outp + (size_t)m * DM, a.in[9] + DM, nullptr, lane);
    } else if (ph == 9) {
      for (int m = gw; m < MT; m += NGW) row_mla((const bf16*)(ws + A_DQ) + (size_t)m * 1280, m, a.in[14], a.in[17], ws, outp, lane);
      { const size_t ng = (size_t)16 * 2048 * 64;
#define CVT_C_LD(i, va, vb) const size_t g##va = (i); const float* s##va = a.in[4] + g##va * 8; const f32x4 va = *(const f32x4*)s##va, vb = *(const f32x4*)(s##va + 4)
#define CVT_C_ST(va, vb) *(u32x4*)((bf16*)(ws + A_CKVS) + (g##va / (2048 * 64)) * 2112 * 512 + (g##va % (2048 * 64)) * 8) = pack8(va, vb)
        size_t i = gt;
        for (; i + 3 * NGT < ng; i += 4 * NGT) { CVT_C_LD(i, p0, p1); CVT_C_LD(i + NGT, q0, q1); CVT_C_LD(i + 2 * NGT, r0, r1); CVT_C_LD(i + 3 * NGT, t0, t1);
          CVT_C_ST(p0, p1); CVT_C_ST(q0, q1); CVT_C_ST(r0, r1); CVT_C_ST(t0, t1); }
        for (; i < ng; i += NGT) { CVT_C_LD(i, p0, p1); CVT_C_ST(p0, p1); }
#undef CVT_C_LD
#undef CVT_C_ST
      }
      { const size_t ng = (size_t)16 * 2048 * 8;
        for (size_t i = gt; i < ng; i += NGT) { const size_t rowi = i >> 3; const int q = (int)(i & 7); const size_t b = rowi / 2048, r = rowi % 2048;
          const float* src = a.in[5] + rowi * 64 + 4 * q; const f32x4 x1 = *(const f32x4*)src, x2 = *(const f32x4*)(src + 32);
          u32x4 w; w.x = cvtpk(x1.x, x2.x); w.y = cvtpk(x1.y, x2.y); w.z = cvtpk(x1.z, x2.z); w.w = cvtpk(x1.w, x2.w);
          *(u32x4*)((bf16*)(ws + A_KRS) + (b * 2112 + r) * 64 + 8 * q) = w; } }
    } else if (ph == 2) {
      const float C = 0.08838834764831845f * LOG2E;
      for (int u = blockIdx.x; u < 1280; u += G) {
        att::Unit U; U.Qr = nullptr; U.KR = nullptr; U.ldq = 2048; U.ldk = 2048; U.ldo = 2048;
        if (u < 1024) { const int h = u & 15, qb = (u >> 4) & 15, b = u >> 8, c0 = qb * 4, kc0 = c0 > 8 ? c0 - 8 : 0;
          const size_t rq = (size_t)b * 4096 + qb * 256, rk = (size_t)b * 4096 + kc0 * 64;
          U.Q = (const bf16*)(ws + A_Q0) + rq * 2048 + h * 128; U.K = (const bf16*)(ws + A_KP) + rk * 2048 + h * 128; U.V = (const bf16*)(ws + A_VP) + rk * 2048 + h * 128;
          U.O = (bf16*)(ws + A_O0) + rq * 2048 + h * 128; U.nt = c0 + 4 - kc0; U.nact = 8; U.thi0 = c0 - kc0; U.tlo0 = c0 - 8 - kc0; U.qrel0 = (c0 - kc0) * 64; U.bias = a.in[12] + h * 513;
        } else { const int us = u - 1024, h = us & 15, b = us >> 4; const size_t rq = (size_t)NPR + b * 64;
          U.Q = (const bf16*)(ws + A_Q0) + rq * 2048 + h * 128; U.K = (const bf16*)(ws + A_KS) + (size_t)b * 576 * 2048 + h * 128; U.V = (const bf16*)(ws + A_VS) + (size_t)b * 576 * 2048 + h * 128;
          U.O = (bf16*)(ws + A_O0) + rq * 2048 + h * 128; U.nt = 9; U.nact = 2; U.thi0 = 8; U.tlo0 = 0; U.qrel0 = 512; U.bias = a.in[12] + h * 513; }
#ifndef NO_BAND
        att::attn_unit<true, BAND_SD>(U, (LAS char*)lds, C);
#endif
      }
    } else if (ph == 12 || ph == 14) {
      const float C = 0.07216878364870322f * LOG2E;
      const int nunits = ph == 12 ? 1024 : 256;
      for (int i = blockIdx.x; i < nunits; i += G) {
        att::Unit U; U.ldq = 3072; U.ldk = 4096; U.ldo = 2048; U.bias = nullptr; U.qrel0 = 0; U.tlo0 = -100000;
        if (ph == 12) { const int rnd = i >> 8, v = i & 255, bh = v >> 2, s = v & 3, qb = rnd == 0 ? s : rnd == 1 ? 7 - s : rnd == 2 ? 8 + s : 15 - s, b = bh >> 4, h = bh & 15;
          const size_t rq = (size_t)b * 4096 + qb * 256, rk = (size_t)b * 4096;
          U.Q = (const bf16*)(ws + A_QM) + rq * 3072 + h * 128; U.Qr = (const bf16*)(ws + A_QM) + rq * 3072 + 2048 + h * 64;
          U.K = (const bf16*)(ws + A_KNV) + rk * 4096 + h * 128; U.V = (const bf16*)(ws + A_KNV) + rk * 4096 + 2048 + h * 128; U.KR = (const bf16*)(ws + A_KRP) + rk * 64;
          U.O = (bf16*)(ws + A_O1) + rq * 2048 + h * 128; U.nt = qb * 4 + 4; U.nact = 8; U.thi0 = qb * 4;
        } else { const int b = i >> 4, h = i & 15; const size_t rq = (size_t)NPR + b * 64, rk = (size_t)b * 2112;
          U.Q = (const bf16*)(ws + A_QM) + rq * 3072 + h * 128; U.Qr = (const bf16*)(ws + A_QM) + rq * 3072 + 2048 + h * 64;
          U.K = (const bf16*)(ws + A_KNV) + rk * 4096 + h * 128; U.V = (const bf16*)(ws + A_KNV) + rk * 4096 + 2048 + h * 128; U.KR = (const bf16*)(ws + A_KRS) + rk * 64;
          U.O = (bf16*)(ws + A_O1) + rq * 2048 + h * 128; U.nt = 33; U.nact = 2; U.thi0 = 32; }
#ifndef NO_MLA
        att::attn_unit<false, MLA_SD>(U, (LAS char*)lds, C);
#endif
      }
    }
    if (it_ + 1 < a_.ph_hi && ph != 10) { if (a_.ph_hi > 1000) grid.sync(); else xcd_barrier(xbar);
      for (int e_ = 0; e_ < PROBE_SYNC; ++e_) xcd_barrier(xbar); }
  }
}

#ifndef MULTI_LAUNCH
#define MULTI_LAUNCH 0
#endif
extern "C" void kernel_launch(void* const* d_in, const int* in_sizes, int n_in, void* d_out, int out_size, void* d_ws, size_t ws_size, hipStream_t stream) {
  static int grid = 0;
  if (grid == 0) {
    if (n_in != 23 || out_size != (int)O_END || ws_size < WS_NEED) { fprintf(stderr, "kernel_launch: unexpected shapes n_in %d out %d ws %zu (need %zu)\n", n_in, out_size, ws_size, (size_t)WS_NEED); grid = -1; return; }
    int dev = 0, cus = 0, per_cu = 0;
    hipGetDevice(&dev); hipDeviceGetAttribute(&cus, hipDeviceAttributeMultiprocessorCount, dev);
    if (hipFuncSetAttribute((const void*)fwd_mega, hipFuncAttributeMaxDynamicSharedMemorySize, LDS_BYTES) != hipSuccess) { fprintf(stderr, "hipFuncSetAttribute failed\n"); grid = -1; return; }
    hipOccupancyMaxActiveBlocksPerMultiprocessor(&per_cu, (const void*)fwd_mega, 512, LDS_BYTES);
    (void)hipGetLastError();
    if (per_cu < 1) per_cu = 1;
    grid = cus;
  }
  if (grid < 0) return;
  if (hipMemsetAsync((char*)d_ws + A_BAR, 0, 16384, stream) != hipSuccess) { fprintf(stderr, "memset failed\n"); return; }
  Args a{};
  for (int i = 0; i < 23; ++i) a.in[i] = (const float*)d_in[i];
  a.out = (float*)d_out; a.ws = (unsigned char*)d_ws;
#if MULTI_LAUNCH
  for (int ph = 0; ph < NSTEPS; ++ph) { a.ph_lo = ph; a.ph_hi = ph + 1; hipLaunchKernelGGL(fwd_mega, dim3(grid), dim3(512), LDS_BYTES, stream, a); }
#else
  a.ph_lo = 0; a.ph_hi = NSTEPS + PROBE_REP;
  void* args[] = {&a};
  hipError_t e = hipLaunchCooperativeKernel((const void*)fwd_mega, dim3(grid), dim3(512), args, LDS_BYTES, stream);
  if (e != hipSuccess) fprintf(stderr, "cooperative launch failed: %s (grid %d)\n", hipGetErrorString(e), grid);
#endif
}
```

```cpp
#include <hip/hip_runtime.h>
#include <hip/hip_cooperative_groups.h>
#include <cstdio>
#include <cstdint>
namespace cg = cooperative_groups;
namespace pg8 {
#define PG8_LAS __attribute__((address_space(3)))
typedef unsigned short bf16_t;
typedef short bf16x8 __attribute__((ext_vector_type(8)));
typedef float f32x4 __attribute__((ext_vector_type(4)));
typedef unsigned u32x4 __attribute__((ext_vector_type(4)));
constexpr int BM = 256, BK = 64, HALF = 128, HTB = HALF * BK * 2  , STAGE_BYTES = 8 * HTB, NXCD = 8, WGM = 8;

__host__ __device__ __forceinline__ int lds_byte(int r, int c) { const int st = (r >> 4) * 2 + (c >> 5), rr = r & 15, cc = c & 31, ob = rr * 64 + cc * 2; return st * 1024 + (ob ^ (((ob >> 9) & 1) << 5)); }
__host__ __device__ __forceinline__ void stage_rc(int b, int& R, int& C) { const int st = b / 1024, sb = b % 1024, swz = sb ^ (((sb >> 9) & 1) << 5); R = (st >> 1) * 16 + swz / 64; C = (st & 1) * 32 + (swz % 64) / 2; }
__host__ __device__ __forceinline__ int perm32(int rho) { const int n = rho >> 4, i = rho & 15; return 8 * (i >> 2) + 4 * n + (i & 3); }

struct Unit { int pm, pn, kb, nk, part; };
struct Gemm { const bf16_t* A; const bf16_t* Bt; int M, N, K, lda; };

struct StaticOrder {
    int nM, nN, nwg, G, c, KT, ns;
    __host__ __device__ __forceinline__ void init(int M, int N, int K, int G_, int c_, int ns_) { nM = M / BM; nN = N / BM; nwg = nM * nN; G = G_; c = c_; KT = K / BK; ns = ns_; }
    __host__ __device__ __forceinline__ bool next(int i, Unit& uo) const {
        if (ns == 8) {
            const int L = i * G + c; Unit u;
            if (L < 512) {
                int wgid = L; { const int q = 512 / NXCD, xcd = wgid % NXCD, off = wgid / NXCD; wgid = xcd * q + off; }
                const int nig = WGM * nN; const int gid = wgid / nig, fm = gid * WGM;
                u.pm = fm + ((wgid % nig) / nN); u.pn = (wgid % nig) % nN; u.kb = 0; u.nk = KT; u.part = 2;
            } else {
                const int q = L - 512, t = q % 32, kp = q / 32;
                u.pm = 64 + t / 8; u.pn = t % 8; u.nk = KT / 8; u.kb = kp * u.nk; u.part = 16 + kp;
            }
            uo = u; return L < 768;
        }
        const int np = nwg * ns;
        const int L = i * G + c; const bool ok = L < np;
        int wgid = L; { const int q = np / NXCD, r = np % NXCD, xcd = wgid % NXCD, off = wgid / NXCD; wgid = (xcd < r ? xcd * (q + 1) : r * (q + 1) + (xcd - r) * q) + off; }
        const int half = wgid >= nwg ? 1 : 0; wgid -= half * nwg;
        const int nig = WGM * nN, gid = wgid / nig, fm = gid * WGM, gsz = (nM - fm) < WGM ? (nM - fm) : WGM;
        Unit u; u.pm = fm + ((wgid % nig) % gsz); u.pn = (wgid % nig) / gsz; u.nk = KT / ns; u.kb = half * u.nk; u.part = ns == 2 ? half : 2;
        uo = u; return ok;
    }
    __device__ __forceinline__ void a_ready(const Unit&) const {}
    __device__ __forceinline__ void done(const Unit&) const {}
};
__device__ __forceinline__ unsigned cvt_pk_bf16(float lo, float hi) { unsigned r; asm volatile("v_cvt_pk_bf16_f32 %0, %1, %2" : "=v"(r) : "v"(lo), "v"(hi)); return r; }
template <class Epi, class Sched, bool ALIGN_EPI = false, bool SP2 = false>
__device__ __forceinline__ void gemm_phase(PG8_LAS unsigned char* lds, const Gemm g, const Sched& S, const Epi& E) {
    int tid = threadIdx.x; asm volatile("" : "+v"(tid)); const int wid = __builtin_amdgcn_readfirstlane(tid >> 6), lane = tid & 63, wr = wid >> 2, wc = wid & 3, fr = lane & 15, fq = lane >> 4;
    const int K = g.K;
    unsigned voffA[2], voffB[2];
#pragma unroll
    for (int i = 0; i < 2; ++i) { int R, C; stage_rc(tid * 16 + i * 8192, R, C); const int Rb = Epi::PERM ? ((R & ~31) + perm32(R & 31)) : R;
        voffA[i] = (unsigned)(R * g.lda + C) * 2u; voffB[i] = (unsigned)(Rb * K + C) * 2u; }
    const size_t kstep = (size_t)(BK * 2);
    const size_t hstep = (size_t)HALF * K * 2;
    const size_t tstep = 2 * hstep;
    const size_t hstepA = (size_t)HALF * g.lda * 2, tstepA = 2 * hstepA;
    const unsigned ldsw = (unsigned)wid * 1024u;
    const int aoff = lds_byte(wr * 64 + fr, fq * 8), boff = lds_byte(wc * 32 + fr, fq * 8);
#define PG8_SA(b, h) (((b) * 2 + (h)) * HTB)
#define PG8_SB(b, h) ((4 + (b) * 2 + (h)) * HTB)
#define PG8_STAGE(bufoff, gbase, voff) do { _Pragma("unroll") for (int _i = 0; _i < 2; ++_i) \
        __builtin_amdgcn_global_load_lds((const unsigned*)((const char*)(gbase) + (voff)[_i]), (PG8_LAS unsigned*)(lds + (bufoff) + ldsw + _i * 8192), 16, 0, 0); } while (0)
#define PG8_LDA(dst, b, h) do { _Pragma("unroll") for (int m = 0; m < 4; ++m) _Pragma("unroll") for (int k = 0; k < 2; ++k) dst[m][k] = *(const PG8_LAS bf16x8*)(lds + PG8_SA(b, h) + aoff + m * 2048 + k * 1024); } while (0)
#define PG8_LDB(dst, b, h) do { _Pragma("unroll") for (int n = 0; n < 2; ++n) _Pragma("unroll") for (int k = 0; k < 2; ++k) dst[n][k] = *(const PG8_LAS bf16x8*)(lds + PG8_SB(b, h) + boff + n * 2048 + k * 1024); } while (0)
#define PG8_MMA(ai, bj, At, Bt) do { __builtin_amdgcn_s_setprio(1); _Pragma("unroll") for (int m = 0; m < 4; ++m) _Pragma("unroll") for (int n = 0; n < 2; ++n) _Pragma("unroll") for (int k = 0; k < 2; ++k) \
        acc[ai][bj][m][n] = __builtin_amdgcn_mfma_f32_16x16x32_bf16(Bt[n][k], At[m][k], acc[ai][bj][m][n], 0, 0, 0); __builtin_amdgcn_s_setprio(0); } while (0)
#define PG8_WAIT_V(n) asm volatile("s_waitcnt vmcnt(" #n ")" ::: "memory")
#define PG8_WAIT_L(n) asm volatile("s_waitcnt lgkmcnt(" #n ")" ::: "memory")
#define PG8_BAR __builtin_amdgcn_s_barrier()
#define PG8_SCHED __builtin_amdgcn_sched_barrier(0)
    Unit cur, nxt; int ui = 0;
    if (!S.next(0, cur)) return;
    f32x4 acc[2][2][4][2];
#pragma unroll
    for (int a = 0; a < 2; ++a)
#pragma unroll
        for (int b = 0; b < 2; ++b)
#pragma unroll
            for (int m = 0; m < 4; ++m)
#pragma unroll
                for (int n = 0; n < 2; ++n) acc[a][b][m][n] = (f32x4){0.f, 0.f, 0.f, 0.f};
    bf16x8 At[4][2], B0[2][2], B1[2][2];
    const char* cA = (const char*)g.A + (size_t)cur.pm * tstepA + (size_t)cur.kb * kstep; const char* cB = (const char*)g.Bt + (size_t)cur.pn * tstep + (size_t)cur.kb * kstep;
    S.a_ready(cur);
    if constexpr (SP2) {
        PG8_STAGE(PG8_SB(0, 0), cB, voffB); PG8_STAGE(PG8_SB(0, 1), cB + hstep, voffB); PG8_STAGE(PG8_SA(0, 0), cA, voffA); PG8_STAGE(PG8_SA(0, 1), cA + hstepA, voffA);
        if (wr == 1) PG8_BAR;
        PG8_WAIT_V(2); PG8_BAR;
        PG8_STAGE(PG8_SB(1, 0), cB + kstep, voffB); PG8_STAGE(PG8_SA(1, 0), cA + kstep, voffA); PG8_STAGE(PG8_SB(1, 1), cB + hstep + kstep, voffB);
        PG8_WAIT_V(6); PG8_BAR;
    } else {
        PG8_STAGE(PG8_SB(0, 0), cB, voffB); PG8_STAGE(PG8_SA(0, 0), cA, voffA); PG8_STAGE(PG8_SB(0, 1), cB + hstep, voffB); PG8_STAGE(PG8_SA(0, 1), cA + hstepA, voffA);
        if (wr == 1) PG8_BAR;
        PG8_WAIT_V(4); PG8_BAR;
        PG8_STAGE(PG8_SB(1, 0), cB + kstep, voffB); PG8_STAGE(PG8_SA(1, 0), cA + kstep, voffA); PG8_STAGE(PG8_SB(1, 1), cB + hstep + kstep, voffB);
        PG8_WAIT_V(6); PG8_BAR;
    }
    for (;;) {
        const bool has_next = S.next(ui + 1, nxt);
        const char* nA = has_next ? (const char*)g.A + (size_t)nxt.pm * tstepA + (size_t)nxt.kb * kstep : cA; const char* nB = has_next ? (const char*)g.Bt + (size_t)nxt.pn * tstep + (size_t)nxt.kb * kstep : cB;
        const int nt = cur.nk;
        for (int t = 0; t < nt; t += 2) {
            const bool last = (t == nt - 2);
            const char* a1 = cA + (size_t)(t + 1) * kstep;
            const char* a2 = last ? nA : cA + (size_t)(t + 2) * kstep; const char* b2 = last ? nB : cB + (size_t)(t + 2) * kstep;
            const char* a3 = a2 + kstep; const char* b3 = b2 + kstep;
            if (last && has_next) S.a_ready(nxt);
            if constexpr (SP2) {
            PG8_LDB(B0, 0, 0); PG8_LDB(B1, 0, 1); PG8_SCHED; PG8_LDA(At, 0, 0); PG8_STAGE(PG8_SA(1, 1), a1 + hstepA, voffA);
            PG8_WAIT_V(8); PG8_WAIT_L(0); PG8_BAR; PG8_MMA(0, 0, At, B0); PG8_MMA(0, 1, At, B1); PG8_BAR; PG8_SCHED;
            PG8_LDA(At, 0, 1); PG8_STAGE(PG8_SB(0, 0), b2, voffB); PG8_STAGE(PG8_SB(0, 1), b2 + hstep, voffB); PG8_STAGE(PG8_SA(0, 0), a2, voffA);
            PG8_WAIT_V(8); PG8_WAIT_L(0); PG8_BAR; PG8_MMA(1, 0, At, B0); PG8_MMA(1, 1, At, B1); PG8_BAR; PG8_SCHED;
            PG8_LDB(B0, 1, 0); PG8_LDB(B1, 1, 1); PG8_SCHED; PG8_LDA(At, 1, 0); PG8_STAGE(PG8_SA(0, 1), a2 + hstepA, voffA);
            PG8_WAIT_V(8); PG8_WAIT_L(0); PG8_BAR; PG8_MMA(0, 0, At, B0); PG8_MMA(0, 1, At, B1); PG8_BAR; PG8_SCHED;
            PG8_LDA(At, 1, 1); PG8_STAGE(PG8_SB(1, 0), b3, voffB); PG8_STAGE(PG8_SB(1, 1), b3 + hstep, voffB); PG8_STAGE(PG8_SA(1, 0), a3, voffA);
            PG8_WAIT_V(8); PG8_WAIT_L(0); PG8_BAR; PG8_MMA(1, 0, At, B0); PG8_MMA(1, 1, At, B1); PG8_BAR; PG8_SCHED;
            } else {
            PG8_LDB(B0, 0, 0); PG8_SCHED; PG8_LDA(At, 0, 0); PG8_STAGE(PG8_SA(1, 1), a1 + hstepA, voffA);
            PG8_WAIT_L(8); PG8_BAR; PG8_WAIT_L(0); PG8_MMA(0, 0, At, B0); PG8_BAR; PG8_SCHED;
            PG8_LDB(B1, 0, 1); PG8_STAGE(PG8_SB(0, 0), b2, voffB);
            PG8_BAR; PG8_WAIT_L(0); PG8_MMA(0, 1, At, B1); PG8_BAR;
            PG8_LDA(At, 0, 1); PG8_STAGE(PG8_SA(0, 0), a2, voffA);
            PG8_BAR; PG8_WAIT_L(0); PG8_MMA(1, 0, At, B0); PG8_BAR; PG8_SCHED;
            PG8_STAGE(PG8_SB(0, 1), b2 + hstep, voffB);
            PG8_WAIT_V(6); PG8_BAR; PG8_MMA(1, 1, At, B1); PG8_BAR;
            PG8_LDB(B0, 1, 0); PG8_SCHED; PG8_LDA(At, 1, 0); PG8_STAGE(PG8_SA(0, 1), a2 + hstepA, voffA);
            PG8_WAIT_L(8); PG8_BAR; PG8_WAIT_L(0); PG8_MMA(0, 0, At, B0); PG8_BAR; PG8_SCHED;
            PG8_LDB(B1, 1, 1); PG8_STAGE(PG8_SB(1, 0), b3, voffB);
            PG8_BAR; PG8_WAIT_L(0); PG8_MMA(0, 1, At, B1); PG8_BAR;
            PG8_LDA(At, 1, 1); PG8_STAGE(PG8_SA(1, 0), a3, voffA);
            PG8_BAR; PG8_WAIT_L(0); PG8_MMA(1, 0, At, B0); PG8_BAR; PG8_SCHED;
            PG8_STAGE(PG8_SB(1, 1), b3 + hstep, voffB);
            PG8_WAIT_V(6); PG8_BAR; PG8_MMA(1, 1, At, B1); PG8_BAR;
            }
        }
        if constexpr (ALIGN_EPI) { if (wr == 0) PG8_BAR; }
        if constexpr (!Epi::AFTER_DRAIN) { E(acc, cur, wr, wc, fr, fq); S.done(cur); }
        if (!has_next) break;
#pragma unroll
        for (int a = 0; a < 2; ++a)
#pragma unroll
            for (int b = 0; b < 2; ++b)
#pragma unroll
                for (int m = 0; m < 4; ++m)
#pragma unroll
                    for (int n = 0; n < 2; ++n) acc[a][b][m][n] = (f32x4){0.f, 0.f, 0.f, 0.f};
        cur = nxt; cA = nA; cB = nB; ++ui;
        if constexpr (ALIGN_EPI) { if (wr == 1) PG8_BAR; }
    }
    PG8_WAIT_V(0);
    if constexpr (!ALIGN_EPI) { if (wr == 0) PG8_BAR; }
    PG8_BAR;
    if constexpr (Epi::AFTER_DRAIN) { E.fused(acc, cur, wr, wc, fr, fq, lds, wid, lane); S.done(cur); }
#undef PG8_SA
#undef PG8_SB
#undef PG8_STAGE
#undef PG8_LDA
#undef PG8_LDB
#undef PG8_MMA
#undef PG8_WAIT_V
#undef PG8_WAIT_L
#undef PG8_BAR
#undef PG8_SCHED
}
}
#define LAS __attribute__((address_space(3)))
#define DI __device__ __forceinline__
typedef unsigned short bf16;
typedef float f32x4 __attribute__((ext_vector_type(4)));
typedef float f32x8 __attribute__((ext_vector_type(8)));
typedef float f32x16 __attribute__((ext_vector_type(16)));
typedef short bf16x8 __attribute__((ext_vector_type(8)));
typedef short s16x4 __attribute__((ext_vector_type(4)));
typedef unsigned u32x4 __attribute__((ext_vector_type(4)));
typedef unsigned u32x2 __attribute__((ext_vector_type(2)));

constexpr int DM = 2048, NPR = 16384, NSA = 1024, MT = NPR + NSA, SEQ = 4096, DEC = 64, PAST = 2048, DFF = 8192;
constexpr float EPS = 1e-6f;
constexpr float LOG2E = 1.4426950408889634f;

constexpr size_t O_Y = 0, O_AKP = 35651584, O_AVP = 39845888, O_AKS = 44040192, O_AVS = 46137344,
                 O_CKVP = 48234496, O_KRP = 56623104, O_CKVS = 57671680, O_KRS = 58195968, O_END = 58261504;
constexpr size_t MiB = 1u << 20;
constexpr size_t W_QKV = 0, W_AO = 24 * MiB, W_D = 32 * MiB, W_UQ = 37 * MiB, W_UKV = 40 * MiB, W_MO = 44 * MiB, W_F1 = 52 * MiB, W_F2 = 84 * MiB;
constexpr size_t A_H = 116 * MiB, A_T = 184 * MiB, A_R = 252 * MiB;
constexpr size_t A_Q0 = A_R, A_KP = A_R + 68 * MiB, A_VP = A_KP + 64 * MiB, A_KS = A_VP + 64 * MiB, A_VS = A_KS + 36 * MiB, A_O0 = A_VS + 36 * MiB;
constexpr size_t A_PF = 528 * MiB;
constexpr size_t A_HID = A_R;
constexpr size_t A_CKVP = A_R, A_CKVS = A_R + 16 * MiB, A_KRP = A_CKVS + 33 * MiB, A_KRS = A_KRP + 2 * MiB, A_QM = A_KRS + 5 * MiB, A_KNV = A_QM + 102 * MiB;
constexpr size_t A_DQ = A_KNV, A_CQ = A_KNV + 130 * MiB, A_O1 = A_H;
constexpr size_t A_BAR = A_KNV + 264 * MiB;
constexpr size_t A_RSTD = A_BAR + 65536;
constexpr size_t WS_NEED = A_RSTD + 131072;

DI unsigned cvtpk(float lo, float hi) { unsigned r; asm volatile("v_cvt_pk_bf16_f32 %0, %1, %2" : "=v"(r) : "v"(lo), "v"(hi)); return r; }
DI float bflo(unsigned w) { return __uint_as_float(w << 16); }
DI float bfhi(unsigned w) { return __uint_as_float(w & 0xffff0000u); }
DI float wave_sum(float v) {
  v += __int_as_float(__builtin_amdgcn_ds_swizzle(__float_as_int(v), (1 << 10) | 0x1f));
  v += __int_as_float(__builtin_amdgcn_ds_swizzle(__float_as_int(v), (2 << 10) | 0x1f));
  v += __int_as_float(__builtin_amdgcn_ds_swizzle(__float_as_int(v), (4 << 10) | 0x1f));
  v += __int_as_float(__builtin_amdgcn_ds_swizzle(__float_as_int(v), (8 << 10) | 0x1f));
  v += __int_as_float(__builtin_amdgcn_ds_swizzle(__float_as_int(v), (16 << 10) | 0x1f));
  auto rr = __builtin_amdgcn_permlane32_swap(__float_as_uint(v), __float_as_uint(v), false, false);
  return __uint_as_float(rr[0]) + __uint_as_float(rr[1]);
}
DI u32x4 pack8(f32x4 a, f32x4 b) { u32x4 w; w.x = cvtpk(a.x, a.y); w.y = cvtpk(a.z, a.w); w.z = cvtpk(b.x, b.y); w.w = cvtpk(b.z, b.w); return w; }


DI void sincos_cw(float x, float& sn, float& cs) {
  const float k = rintf(x * 0.63661977236758134f);
  float r = fmaf(-k, 1.5703125f, x); r = fmaf(-k, 4.837512969970703125e-4f, r); r = fmaf(-k, 7.54978995489188216e-8f, r);
  const float z = r * r;
  const float sp = fmaf(r * z, fmaf(z, fmaf(z, -1.9515295891e-4f, 8.3321608736e-3f), -1.6666654611e-1f), r);
  const float cp = fmaf(z * z, fmaf(z, fmaf(z, 2.443315711809948e-5f, -1.388731625493765e-3f), 4.166664568298827e-2f), fmaf(z, -0.5f, 1.0f));
  const int q = ((int)k) & 3;
  const float s1 = (q & 1) ? cp : sp, c1 = (q & 1) ? sp : cp;
  sn = (q & 2) ? -s1 : s1; cs = ((q + 1) & 2) ? -c1 : c1;
}
enum { EM_BF16 = 0, EM_QKV = 1, EM_RELU2 = 2, EM_F32 = 3, EM_QROPE = 4, EM_SPLIT = 5, EM_TAIL = 6 };
struct EpiMode {
  static constexpr bool PERM = true, AFTER_DRAIN = false;
  int mode; bf16* O; int ldc; float* F; float* outp;
  bf16* O2;
  const float* rs;
  unsigned char* ws;
  template <int MODE> DI void store8(int row, int col, f32x4 v0, f32x4 v1, int part) const {
    if (MODE == EM_QKV || MODE == EM_RELU2 || MODE == EM_F32) { const float r_ = rs[row]; v0 *= r_; v1 *= r_; }
    if (MODE == EM_TAIL) {
      if (part >= 16) *(u32x4*)(O2 + ((size_t)(part - 16) * 1024 + (row - NPR)) * 2048 + col) = pack8(v0, v1);
      else *(u32x4*)(O + (size_t)row * ldc + col) = pack8(v0, v1);
    } else if (MODE == EM_SPLIT) {
      bf16* d = (part & 1) ? O2 : O; *(u32x4*)(d + (size_t)row * ldc + col) = pack8(v0, v1);
      if (part & 2) *(u32x4*)(O2 + (size_t)row * ldc + col) = (u32x4){0u, 0u, 0u, 0u};
    } else if (MODE == EM_BF16) { *(u32x4*)(O + (size_t)row * ldc + col) = pack8(v0, v1); }
    else if (MODE == EM_RELU2) {
      f32x4 a = __builtin_elementwise_max(v0, (f32x4){0.f, 0.f, 0.f, 0.f}), b = __builtin_elementwise_max(v1, (f32x4){0.f, 0.f, 0.f, 0.f});
      *(u32x4*)(O + (size_t)row * ldc + col) = pack8(a * a, b * b); }
    else if (MODE == EM_F32) { if (col < 1088) *(u32x4*)((bf16*)F + (size_t)row * ldc + col) = pack8(v0, v1); }
    else if (MODE == EM_QKV) {
      const u32x4 w = pack8(v0, v1);
      if (col < 2048) { *(u32x4*)((bf16*)(ws + A_Q0) + (size_t)row * 2048 + col) = w; }
      else {
        const int isv = col >= 4096; const int c = col - (isv ? 4096 : 2048);
        if (row < NPR) {
          *(u32x4*)((bf16*)(ws + (isv ? A_VP : A_KP)) + (size_t)row * 2048 + c) = w;
          const int s = row & 4095, b = row >> 12;
          if (s >= 3584) { float* p = outp + (isv ? O_AVP : O_AKP) + ((size_t)(b * 512 + s - 3584)) * 2048 + c; *(f32x4*)p = v0; *(f32x4*)(p + 4) = v1; }
        } else {
          const int rs = row - NPR, b = rs >> 6, i = rs & 63;
          *(u32x4*)((bf16*)(ws + (isv ? A_VS : A_KS)) + ((size_t)(b * 576 + 512 + i)) * 2048 + c) = w;
          float* p = outp + (isv ? O_AVS : O_AKS) + (size_t)rs * 2048 + c; *(f32x4*)p = v0; *(f32x4*)(p + 4) = v1;
        }
      }
    } else if (MODE == EM_QROPE) {
      if (col >= 2048) {
        const int j = col - 2048, i0 = (j & 63) >> 1;
        const float pos = (float)(row < NPR ? (row & 4095) : PAST + ((row - NPR) & 63));
        float x[8] = {v0.x, v0.y, v0.z, v0.w, v1.x, v1.y, v1.z, v1.w};
#pragma unroll
        for (int p = 0; p < 4; ++p) {
          const float inv = exp2f(-(float)(i0 + p) * 0.41524101186092029f);
          float sn, cs; sincos_cw(pos * inv, sn, cs);
          const float a = x[2 * p], b = x[2 * p + 1];
          x[2 * p] = a * cs - b * sn; x[2 * p + 1] = b * cs + a * sn;
        }
        v0 = (f32x4){x[0], x[1], x[2], x[3]}; v1 = (f32x4){x[4], x[5], x[6], x[7]};
      }
      *(u32x4*)(O + (size_t)row * ldc + col) = pack8(v0, v1);
    }
  }
  template <int MODE> DI void run(const f32x4 (&acc)[2][2][4][2], const pg8::Unit& u, int wr, int wc, int fr, int fq) const {
#pragma unroll
    for (int ai = 0; ai < 2; ++ai)
#pragma unroll
      for (int m = 0; m < 4; ++m) {
        const int row = u.pm * 256 + ai * 128 + wr * 64 + m * 16 + fr;
#pragma unroll
        for (int bj = 0; bj < 2; ++bj) { store8<MODE>(row, u.pn * 256 + bj * 128 + wc * 32 + 8 * fq, acc[ai][bj][m][0], acc[ai][bj][m][1], u.part);
          if (MODE == EM_QROPE || MODE == EM_QKV) asm volatile("" ::: "memory"); }
      }
  }
  DI void operator()(const f32x4 (&acc)[2][2][4][2], const pg8::Unit& u, int wr, int wc, int fr, int fq) const {
    { int t_ = threadIdx.x; asm volatile("" : "+v"(t_)); fr = t_ & 15; fq = (t_ >> 4) & 3; }
    switch (mode) {
      case EM_BF16: run<EM_BF16>(acc, u, wr, wc, fr, fq); break;
      case EM_RELU2: run<EM_RELU2>(acc, u, wr, wc, fr, fq); break;
      case EM_F32: run<EM_F32>(acc, u, wr, wc, fr, fq); break;
      case EM_QKV: run<EM_QKV>(acc, u, wr, wc, fr, fq); break;
      case EM_SPLIT: run<EM_SPLIT>(acc, u, wr, wc, fr, fq); break;
      case EM_TAIL: run<EM_TAIL>(acc, u, wr, wc, fr, fq); break;
      default: run<EM_QROPE>(acc, u, wr, wc, fr, fq); break;
    }
  }
};
DI void run_gemm(LAS unsigned char* lds, const bf16* A, int lda, const bf16* Bt, int M, int N, int K, const EpiMode& E) {
  pg8::Gemm g{A, Bt, M, N, K, lda}; pg8::StaticOrder S; S.init(M, N, K, (int)gridDim.x, (int)blockIdx.x, E.mode == EM_TAIL ? 8 : E.mode == EM_SPLIT ? 2 : 1);
  pg8::gemm_phase<EpiMode, pg8::StaticOrder, true, true>(lds, g, S, E);
}
DI void row_x_prep(const float* xrow, bf16* xbrow, float* rstd_out, int lane) {
  const f32x4* xr = (const f32x4*)xrow + lane;
  f32x4 v[8]; float s = 0.f;
#pragma unroll
  for (int j = 0; j < 8; ++j) { v[j] = xr[64 * j]; s += (v[j].x * v[j].x + v[j].y * v[j].y) + (v[j].z * v[j].z + v[j].w * v[j].w); }
  const float rstd = rsqrtf(wave_sum(s) * (1.f / DM) + EPS);
  u32x2* x8 = (u32x2*)xbrow + lane;
#pragma unroll
  for (int j = 0; j < 8; ++j) { u32x2 w; w.x = cvtpk(v[j].x, v[j].y); w.y = cvtpk(v[j].z, v[j].w); x8[64 * j] = w; }
  if (lane == 0) *rstd_out = rstd;
}
template <bool XINB, bool XOUTB> DI void row_resid_norm(const bf16* trow, const bf16* trow2, int npart, const void* xin, void* xout, const float* gpost, float* rstd_out, int lane) {
  const u32x2* tr = (const u32x2*)trow + lane; const u32x2* tr2 = (const u32x2*)trow2 + lane; const f32x4* gr = (const f32x4*)gpost + lane;
  f32x4 t[8], x[8]; float s = 0.f;
#pragma unroll
  for (int j = 0; j < 8; ++j) {
    if (npart == 8) { f32x4 acc4 = {0.f, 0.f, 0.f, 0.f};
#pragma unroll
      for (int p = 0; p < 8; ++p) { const u32x2 w = (tr2 + (size_t)p * (1024 * 2048 / 4))[64 * j]; acc4 += (f32x4){bflo(w.x), bfhi(w.x), bflo(w.y), bfhi(w.y)}; }
      t[j] = acc4;
    } else { const u32x2 w = tr[64 * j]; u32x2 w2 = {0u, 0u}; if (npart == 1) w2 = tr2[64 * j]; t[j] = (f32x4){bflo(w.x) + bflo(w2.x), bfhi(w.x) + bfhi(w2.x), bflo(w.y) + bflo(w2.y), bfhi(w.y) + bfhi(w2.y)}; }
    s += (t[j].x * t[j].x + t[j].y * t[j].y) + (t[j].z * t[j].z + t[j].w * t[j].w); }
#pragma unroll
  for (int j = 0; j < 8; ++j) { if (XINB) { const u32x2 w = ((const u32x2*)xin + lane)[64 * j]; x[j] = (f32x4){bflo(w.x), bfhi(w.x), bflo(w.y), bfhi(w.y)}; } else x[j] = ((const f32x4*)xin + lane)[64 * j]; }
  const float rstd = rsqrtf(wave_sum(s) * (1.f / DM) + EPS);
  float s2 = 0.f;
#pragma unroll
  for (int j = 0; j < 8; ++j) { const f32x4 gg = gr[64 * j]; x[j] = x[j] + t[j] * rstd * gg; s2 += (x[j].x * x[j].x + x[j].y * x[j].y) + (x[j].z * x[j].z + x[j].w * x[j].w); }
  asm volatile("s_waitcnt vmcnt(0)" ::: "memory");
#pragma unroll
  for (int j = 0; j < 8; ++j) { if (XOUTB) { u32x2 w; w.x = cvtpk(x[j].x, x[j].y); w.y = cvtpk(x[j].z, x[j].w); ((u32x2*)xout + lane)[64 * j] = w; } else ((f32x4*)xout + lane)[64 * j] = x[j]; }
  if (rstd_out) { const float rstd2 = rsqrtf(wave_sum(s2) * (1.f / DM) + EPS); if (lane == 0) *rstd_out = rstd2; }
}
DI bf16* xb_row(float* outp, int m) { return (bf16*)((char*)outp + (size_t)m * 8192 + 4096); }
DI void row_mla(const bf16* d, int row, const float* qn, const float* kvn, unsigned char* ws, float* outp, int lane) {
  f32x4 a[2], c[2]; float sa = 0.f, sc = 0.f;
#pragma unroll
  for (int j = 0; j < 2; ++j) { const u32x2 wa = *(const u32x2*)(d + 4 * lane + 256 * j), wc = *(const u32x2*)(d + 512 + 4 * lane + 256 * j);
    a[j] = (f32x4){bflo(wa.x), bfhi(wa.x), bflo(wa.y), bfhi(wa.y)}; c[j] = (f32x4){bflo(wc.x), bfhi(wc.x), bflo(wc.y), bfhi(wc.y)};
    sa += (a[j].x * a[j].x + a[j].y * a[j].y) + (a[j].z * a[j].z + a[j].w * a[j].w); sc += (c[j].x * c[j].x + c[j].y * c[j].y) + (c[j].z * c[j].z + c[j].w * c[j].w); }
  const float ra = rsqrtf(wave_sum(sa) * (1.f / 512.f) + EPS), rc = rsqrtf(wave_sum(sc) * (1.f / 512.f) + EPS);
  bf16* cq = (bf16*)(ws + A_CQ) + (size_t)row * 512;
  bf16* ckv; bf16* kr; float* fckv; float* fkr;
  if (row < NPR) { ckv = (bf16*)(ws + A_CKVP) + (size_t)row * 512; kr = (bf16*)(ws + A_KRP) + (size_t)row * 64; fckv = outp + O_CKVP + (size_t)row * 512; fkr = outp + O_KRP + (size_t)row * 64; }
  else { const int rs = row - NPR, b = rs >> 6, i = rs & 63; const size_t r2 = (size_t)b * 2112 + 2048 + i;
    ckv = (bf16*)(ws + A_CKVS) + r2 * 512; kr = (bf16*)(ws + A_KRS) + r2 * 64; fckv = outp + O_CKVS + (size_t)rs * 512; fkr = outp + O_KRS + (size_t)rs * 64; }
#pragma unroll
  for (int j = 0; j < 2; ++j) {
    const f32x4 g1 = *(const f32x4*)(qn + 4 * lane + 256 * j), g2 = *(const f32x4*)(kvn + 4 * lane + 256 * j);
    const f32x4 q = a[j] * ra * g1, k = c[j] * rc * g2;
    u32x2 w; w.x = cvtpk(q.x, q.y); w.y = cvtpk(q.z, q.w); *(u32x2*)(cq + 4 * lane + 256 * j) = w;
    w.x = cvtpk(k.x, k.y); w.y = cvtpk(k.z, k.w); *(u32x2*)(ckv + 4 * lane + 256 * j) = w;
    *(f32x4*)(fckv + 4 * lane + 256 * j) = k;
  }
  if (lane < 32) {
    const float x1 = __uint_as_float((unsigned)d[1024 + lane] << 16), x2 = __uint_as_float((unsigned)d[1056 + lane] << 16);
    const float pos = (float)(row < NPR ? (row & 4095) : PAST + ((row - NPR) & 63));
    const float inv = exp2f(-(float)lane * 0.41524101186092029f);
    float sn, cs; sincos_cw(pos * inv, sn, cs);
    const float o1 = x1 * cs - x2 * sn, o2 = x2 * cs + x1 * sn;
    fkr[lane] = o1; fkr[32 + lane] = o2;
    *(unsigned*)(kr + 2 * lane) = cvtpk(o1, o2);
  }
}

DI unsigned f2bf(float f) { unsigned u = __builtin_bit_cast(unsigned, f); return (u + 0x7fffu + ((u >> 16) & 1u)) >> 16; }
DI unsigned pk2(float lo, float hi) { return f2bf(lo) | (f2bf(hi) << 16); }
template <int RMAP> DI void transpose_item(const float* W, int K, int N, bf16* WT, int row_off, LAS float* scr, int item, int lane, const float* gk = nullptr) {
  const int nblk = N / 64, kb = item / nblk, nb = item % nblk, k0 = 64 * kb, n0 = 64 * nb;
  const int lr = lane >> 4, lc = (lane & 15) * 4;
  f32x4 v[16];
#pragma unroll
  for (int i = 0; i < 16; ++i) v[i] = *(const f32x4*)(W + (size_t)(k0 + 4 * i + lr) * N + n0 + lc);
#pragma unroll
  for (int i = 0; i < 16; ++i) { LAS float* d = scr + (4 * i + lr) * 65 + lc; d[0] = v[i].x; d[1] = v[i].y; d[2] = v[i].z; d[3] = v[i].w; }
  asm volatile("s_waitcnt lgkmcnt(0)" ::: "memory");
  const int c = lane & 7;
  f32x4 ga = {1.f, 1.f, 1.f, 1.f}, gb = ga; if (gk) { ga = *(const f32x4*)(gk + k0 + 8 * c); gb = *(const f32x4*)(gk + k0 + 8 * c + 4); }
#pragma unroll
  for (int j = 0; j < 8; ++j) { const int n = (lane >> 3) + 8 * j; const LAS float* s = scr + (8 * c) * 65 + n;
    u32x4 o; o.x = cvtpk(s[0 * 65] * ga.x, s[1 * 65] * ga.y); o.y = cvtpk(s[2 * 65] * ga.z, s[3 * 65] * ga.w); o.z = cvtpk(s[4 * 65] * gb.x, s[5 * 65] * gb.y); o.w = cvtpk(s[6 * 65] * gb.z, s[7 * 65] * gb.w);
    int orow = row_off + n0 + n;
    if (RMAP == 1) { const int nn = n0 + n, h = nn / 192, e = nn % 192; if (e < 128) orow = h * 128 + e; else { const int jj = e - 128; orow = 2048 + h * 64 + (jj < 32 ? 2 * jj : 2 * (jj - 32) + 1); } }
    *(u32x4*)(WT + (size_t)orow * K + k0 + 8 * c) = o; }
  asm volatile("s_waitcnt lgkmcnt(0)" ::: "memory");
}
namespace att {
constexpr int SHM_V = 16384, SHM_K = 64 * 272, SHM_KR = 64 * 144;
constexpr int OFF_V = 0, OFF_K = 2 * SHM_V, OFF_KR = OFF_K + 2 * SHM_K, OFF_WS = OFF_KR + 2 * SHM_KR, OFF_BIAS = OFF_WS + 8 * 64 * 4, LDS_END = OFF_BIAS + 640 * 4;
#define KSWZ(row, colB) ((row) * 272 + (colB))
#define KRSWZ(row, colB) ((row) * 144 + (colB))
#define SBAR() __builtin_amdgcn_sched_barrier(0)
DI int crow(int r, int hi) { return (r & 3) + 8 * (r >> 2) + 4 * hi; }
struct Unit {
  const bf16* Q; const bf16* Qr; int ldq;
  const bf16* K; const bf16* V; const bf16* KR; int ldk;
  bf16* O; int ldo;
  int nt, nact, thi0, tlo0, qrel0;
  int fillb;
  const float* bias;
};
template <bool BAND> DI void partialSM(f32x16& p0, f32x16& p1, float& m_reg, float& mn, float& alpha, bool masked, const LAS float* tb, float C) {
  if (masked) {
#pragma unroll
    for (int r = 0; r < 16; ++r) { p0[r] = -1e30f; p1[r] = -1e30f; }
  } else if (BAND) {
#pragma unroll
    for (int r = 0; r < 16; ++r) { const int ko = (r & 3) + 8 * (r >> 2); p0[r] = fmaf(p0[r], C, tb[ko]); }
    SBAR();
#pragma unroll
    for (int r = 0; r < 16; ++r) { const int ko = (r & 3) + 8 * (r >> 2); p1[r] = fmaf(p1[r], C, tb[ko + 32]); }
  }
  const float CC = BAND ? 1.f : C;
  const float THRP = 11.5f / CC;
  float pmax = p0[0];
#pragma unroll
  for (int r = 1; r < 16; ++r) pmax = fmaxf(pmax, p0[r]);
#pragma unroll
  for (int r = 0; r < 16; ++r) pmax = fmaxf(pmax, p1[r]);
  { auto rr = __builtin_amdgcn_permlane32_swap(__float_as_uint(pmax), __float_as_uint(pmax), false, false);
    pmax = fmaxf(__uint_as_float(rr[0]), __uint_as_float(rr[1])); }
  if (__builtin_expect(__all(pmax - m_reg <= THRP), 1)) { mn = m_reg; alpha = 1.f; }
  else { mn = fmaxf(m_reg, pmax); alpha = __builtin_amdgcn_exp2f((m_reg - mn) * CC); m_reg = mn; }
  const float mnC = -mn * CC;
#pragma unroll
  for (int r = 0; r < 16; ++r) p0[r] = fmaf(p0[r], CC, mnC);
#pragma unroll
  for (int r = 0; r < 16; ++r) p1[r] = fmaf(p1[r], CC, mnC);
#pragma unroll
  for (int r = 0; r < 16; ++r) p0[r] = __builtin_amdgcn_exp2f(p0[r]);
}
DI void finishSM(f32x16& p0, f32x16& p1, float alpha, float& l_reg, bf16x8& pa0, bf16x8& pa1, bf16x8& pa2, bf16x8& pa3) {
#pragma unroll
  for (int r = 0; r < 16; ++r) p1[r] = __builtin_amdgcn_exp2f(p1[r]);
  float ps = 0;
#pragma unroll
  for (int r = 0; r < 16; ++r) ps += p0[r];
#pragma unroll
  for (int r = 0; r < 16; ++r) ps += p1[r];
  { auto rr = __builtin_amdgcn_permlane32_swap(__float_as_uint(ps), __float_as_uint(ps), false, false);
    ps = __uint_as_float(rr[0]) + __uint_as_float(rr[1]); }
  l_reg = l_reg * alpha + ps;
#define PK4(P, BASE, OUT) do { unsigned a0 = cvtpk(P[BASE + 0], P[BASE + 1]), a1 = cvtpk(P[BASE + 2], P[BASE + 3]);   \
    unsigned b0 = cvtpk(P[BASE + 4], P[BASE + 5]), b1 = cvtpk(P[BASE + 6], P[BASE + 7]);                              \
    auto r0 = __builtin_amdgcn_permlane32_swap(a0, b0, false, false); auto r1 = __builtin_amdgcn_permlane32_swap(a1, b1, false, false); \
    u32x4 w = {r0[0], r1[0], r0[1], r1[1]}; OUT = __builtin_bit_cast(bf16x8, w); } while (0)
  PK4(p0, 0, pa0); PK4(p0, 8, pa1); PK4(p1, 0, pa2); PK4(p1, 8, pa3);
#undef PK4
}
template <int NQ> DI void qkt(f32x16& p0, f32x16& p1, const LAS char* Ks, const LAS char* KRs, const bf16x8* qr, int r32, int hi) {
  p0 = f32x16{}; p1 = f32x16{};
#pragma unroll
  for (int d0 = 0; d0 < 8; ++d0) { const int cb = (d0 * 16 + hi * 8) * 2;
    const bf16x8 b0 = *(const LAS bf16x8*)(Ks + KSWZ(r32, cb));
    const bf16x8 b1 = *(const LAS bf16x8*)(Ks + KSWZ(32 + r32, cb));
    p0 = __builtin_amdgcn_mfma_f32_32x32x16_bf16(b0, qr[d0], p0, 0, 0, 0);
    p1 = __builtin_amdgcn_mfma_f32_32x32x16_bf16(b1, qr[d0], p1, 0, 0, 0); }
  if (NQ == 12) {
#pragma unroll
    for (int d0 = 0; d0 < 4; ++d0) { const int cb = (d0 * 16 + hi * 8) * 2;
      const bf16x8 b0 = *(const LAS bf16x8*)(KRs + KRSWZ(r32, cb));
      const bf16x8 b1 = *(const LAS bf16x8*)(KRs + KRSWZ(32 + r32, cb));
      p0 = __builtin_amdgcn_mfma_f32_32x32x16_bf16(b0, qr[8 + d0], p0, 0, 0, 0);
      p1 = __builtin_amdgcn_mfma_f32_32x32x16_bf16(b1, qr[8 + d0], p1, 0, 0, 0); }
  }
}
DI int v_st(int k, int c) { const int kk = (k & ~0xC) | ((k & 4) << 1) | ((k & 8) >> 1); return ((kk >> 3) * 4 + (c >> 5)) * 512 + ((kk & 7) * 32 + (c & 31)) * 2; }
DI int v_rd_base(int lane) { return ((lane & 3) << 3) | (((lane >> 2) & 3) << 6) | (((lane >> 4) & 1) << 5) | (((lane >> 5) & 1) << 8); }
constexpr int v_rd_off(int d0, int ks, int half) { return d0 * 512 + ks * 4096 + half * 2048; }
template <int OFF> DI s16x4 tr_read(int vb) { s16x4 r; asm volatile("ds_read_b64_tr_b16 %0, %1 offset:%2" : "=&v"(r) : "v"(vb), "i"(OFF) : "memory"); return r; }
template <int D0> DI void pv_one(f32x16& od, int vb, bf16x8 pa0, bf16x8 pa1, bf16x8 pa2, bf16x8 pa3) {
  const s16x4 l0 = tr_read<v_rd_off(D0, 0, 0)>(vb), h0 = tr_read<v_rd_off(D0, 0, 1)>(vb), l1 = tr_read<v_rd_off(D0, 1, 0)>(vb), h1 = tr_read<v_rd_off(D0, 1, 1)>(vb);
  const s16x4 l2 = tr_read<v_rd_off(D0, 2, 0)>(vb), h2 = tr_read<v_rd_off(D0, 2, 1)>(vb), l3 = tr_read<v_rd_off(D0, 3, 0)>(vb), h3 = tr_read<v_rd_off(D0, 3, 1)>(vb);
  asm volatile("s_waitcnt lgkmcnt(0)" ::: "memory"); SBAR();
#define PK(L, H) (bf16x8){L[0], L[1], L[2], L[3], H[0], H[1], H[2], H[3]}
  od = __builtin_amdgcn_mfma_f32_32x32x16_bf16(pa0, PK(l0, h0), od, 0, 0, 0);
  od = __builtin_amdgcn_mfma_f32_32x32x16_bf16(pa1, PK(l1, h1), od, 0, 0, 0);
  od = __builtin_amdgcn_mfma_f32_32x32x16_bf16(pa2, PK(l2, h2), od, 0, 0, 0);
  od = __builtin_amdgcn_mfma_f32_32x32x16_bf16(pa3, PK(l3, h3), od, 0, 0, 0);
#undef PK
}
DI void pv_d0(f32x16* o, int vb, bf16x8 pa0, bf16x8 pa1, bf16x8 pa2, bf16x8 pa3) {
  pv_one<0>(o[0], vb, pa0, pa1, pa2, pa3); pv_one<1>(o[1], vb, pa0, pa1, pa2, pa3); pv_one<2>(o[2], vb, pa0, pa1, pa2, pa3); pv_one<3>(o[3], vb, pa0, pa1, pa2, pa3);
}

template <bool BAND, int SD, bool ACT> DI void attn_unit_(const Unit& U, LAS char* lds, float C) {
  constexpr int NQ = BAND ? 8 : 12;
  int tid = threadIdx.x; asm volatile("" : "+v"(tid)); const int wid = __builtin_amdgcn_readfirstlane(tid >> 6), lane = tid & 63, r32 = lane & 31, hi = lane >> 5;
  LAS char* V_lds = lds + OFF_V; LAS char* K_lds = lds + OFF_K; LAS char* KR_lds = lds + OFF_KR;
  LAS float* wsf = (LAS float*)(lds + OFF_WS) + wid * 64; LAS float* li_l = wsf; LAS float* al_l = wsf + 32;
  LAS float* T3 = (LAS float*)(lds + OFF_BIAS);
  const int wq = wid & (U.nact - 1);
  const int cw = wid >> 1; const int t_hi = U.thi0 + cw; const int t_lo = (U.tlo0 + cw) > 0 ? (U.tlo0 + cw) : 0;
  float m_reg = -1e30f, l_reg = 0; f32x16 o[4] = {}; bf16x8 qr[NQ];
  if (ACT) {
    const bf16* Qw = U.Q + (size_t)(wq * 32 + r32) * U.ldq + hi * 8;
#pragma unroll
    for (int d0 = 0; d0 < 8; ++d0) qr[d0] = *(const bf16x8*)(Qw + d0 * 16);
    if (!BAND) { const bf16* Qw2 = U.Qr + (size_t)(wq * 32 + r32) * U.ldq + hi * 8;
#pragma unroll
      for (int d0 = 0; d0 < 4; ++d0) qr[(NQ == 12 ? 8 : 0) + d0] = *(const bf16x8*)(Qw2 + d0 * 16); }
  }
  if (BAND && U.fillb) { for (int j = tid; j < 640; j += 512) { int rel = 575 - j; rel = rel > 256 ? 256 : rel; T3[j] = U.bias[rel + 256] * LOG2E; } }
  const int sr = tid >> 4, sc = (tid & 15) * 8, vst0 = v_st(sr, sc), vst1 = v_st(32 + sr, sc);
  const int krr = tid >> 3, krc = (tid & 7) * 8;
  const int vb0 = (int)(uintptr_t)V_lds + v_rd_base(lane);
  const int jb0 = 575 - U.qrel0 - 32 * wq - r32 + 4 * hi;
  struct { bf16x8 vs0, vs1, ks0, ks1, kr; } sr_[SD];
  const int ntr = U.nt, NT = (U.nt + 1) & ~1;
  const unsigned vo0 = (unsigned)(sr * U.ldk + sc) * 2u, vo1 = (unsigned)((32 + sr) * U.ldk + sc) * 2u, vokr = (unsigned)(krr * 64 + krc) * 2u;
  const size_t tstep = (size_t)64 * U.ldk * 2;
#define SLOAD(i, t) do { const int tt_ = (t) < ntr ? (t) : ntr - 1; const char* kt_ = (const char*)U.K + tt_ * tstep; const char* vt_ = (const char*)U.V + tt_ * tstep;  \
    sr_[i].vs0 = *(const bf16x8*)(vt_ + vo0); sr_[i].vs1 = *(const bf16x8*)(vt_ + vo1);         \
    sr_[i].ks0 = *(const bf16x8*)(kt_ + vo0); sr_[i].ks1 = *(const bf16x8*)(kt_ + vo1);         \
    if (!BAND) sr_[i].kr = *(const bf16x8*)((const char*)U.KR + (size_t)tt_ * 8192 + vokr); } while (0)
#define SWRITE(b, i) do { *(LAS bf16x8*)(V_lds + (b) * SHM_V + vst0) = sr_[i].vs0; *(LAS bf16x8*)(V_lds + (b) * SHM_V + vst1) = sr_[i].vs1; \
    const int kc_ = sc * 2; *(LAS bf16x8*)(K_lds + (b) * SHM_K + KSWZ(sr, kc_)) = sr_[i].ks0; *(LAS bf16x8*)(K_lds + (b) * SHM_K + KSWZ(32 + sr, kc_)) = sr_[i].ks1; \
    if (!BAND) *(LAS bf16x8*)(KR_lds + (b) * SHM_KR + KRSWZ(krr, krc * 2)) = sr_[i].kr; } while (0)
#define SWAIT() do { if (SD == 2) asm volatile("s_waitcnt vmcnt(%0)" ::"n"(BAND ? 4 : 5) : "memory"); else asm volatile("s_waitcnt vmcnt(0)" ::: "memory"); } while (0)
#define RESC(a) do { if (__any((a) < 1.f)) { if (hi == 0) al_l[r32] = (a); asm volatile("s_waitcnt lgkmcnt(0)" ::: "memory"); \
    _Pragma("unroll") for (int d = 0; d < 4; ++d) _Pragma("unroll") for (int r = 0; r < 16; ++r) o[d][r] *= al_l[crow(r, hi)]; } } while (0)
#define MASKED(t) ((t) < t_lo || (t) > t_hi)
  f32x16 pA0, pA1, pB0, pB1; float mnA, mnB, alA = 1.f, alB = 1.f; bf16x8 pa0, pa1, pa2, pa3;
  { u32x4 zz = {0u, 0u, 0u, 0u}; asm volatile("" : "+v"(zz)); pa0 = pa1 = pa2 = pa3 = __builtin_bit_cast(bf16x8, zz); }
  constexpr int SE = 0, SO = SD - 1;
  SLOAD(SE, 0); if (SD == 2) SLOAD(SO, 1);
  if (SD == 2) asm volatile("s_waitcnt vmcnt(%0)" ::"n"(BAND ? 4 : 5) : "memory"); else asm volatile("s_waitcnt vmcnt(0)" ::: "memory");
  SWRITE(0, SE);
  if (SD == 2) { if (2 < NT) SLOAD(SE, 2); } else SLOAD(SO, 1);
  __syncthreads();
  if (ACT) { qkt<NQ>(pA0, pA1, K_lds, KR_lds, qr, r32, hi); partialSM<BAND>(pA0, pA1, m_reg, mnA, alA, MASKED(0), T3 + jb0, C); }
  SWAIT(); SWRITE(1, SO); __syncthreads();
  for (int j = 1; j + 1 < NT; j += 2) {
    SBAR();
    if (ACT) { qkt<NQ>(pB0, pB1, K_lds + SHM_K, KR_lds + SHM_KR, qr, r32, hi); finishSM(pA0, pA1, alA, l_reg, pa0, pa1, pa2, pa3); }
    SBAR();
    SLOAD(SO, j + SD); SBAR();
    if (ACT) { pv_d0(o, vb0, pa0, pa1, pa2, pa3); partialSM<BAND>(pB0, pB1, m_reg, mnB, alB, MASKED(j), T3 + jb0 + 64 * j, C); }
    __syncthreads(); SWAIT(); SWRITE(0, SE);
    if (ACT) RESC(alB);
    __syncthreads();
    SBAR();
    if (ACT) { qkt<NQ>(pA0, pA1, K_lds, KR_lds, qr, r32, hi); finishSM(pB0, pB1, alB, l_reg, pa0, pa1, pa2, pa3); }
    SBAR();
    if (SD == 1 || j + 3 < NT) SLOAD(SE, j + 1 + SD); SBAR();
    if (ACT) { pv_d0(o, vb0 + SHM_V, pa0, pa1, pa2, pa3); partialSM<BAND>(pA0, pA1, m_reg, mnA, alA, MASKED(j + 1), T3 + jb0 + 64 * (j + 1), C); }
    __syncthreads(); SWAIT(); SWRITE(1, SO);
    if (ACT) RESC(alA);
    __syncthreads();
  }
  SBAR();
  if (ACT) {
    qkt<NQ>(pB0, pB1, K_lds + SHM_K, KR_lds + SHM_KR, qr, r32, hi);
    finishSM(pA0, pA1, alA, l_reg, pa0, pa1, pa2, pa3); SBAR();
    pv_d0(o, vb0, pa0, pa1, pa2, pa3); partialSM<BAND>(pB0, pB1, m_reg, mnB, alB, MASKED(NT - 1), T3 + jb0 + 64 * (NT - 1), C);
  }
  __syncthreads();
  if (ACT) {
    RESC(alB);
    finishSM(pB0, pB1, alB, l_reg, pa0, pa1, pa2, pa3); SBAR();
    pv_d0(o, vb0 + SHM_V, pa0, pa1, pa2, pa3);
    if (hi == 0) li_l[r32] = l_reg; asm volatile("s_waitcnt lgkmcnt(0)" ::: "memory");
    float rli[16];
#pragma unroll
    for (int r = 0; r < 16; ++r) rli[r] = __builtin_amdgcn_rcpf(li_l[crow(r, hi)]);
    LAS char* stg = lds + (wid < 2 ? OFF_V + wid * 8192 : OFF_K + (wid - 2) * 8192);
#pragma unroll
    for (int r = 0; r < 16; ++r) { const int orow = crow(r, hi);
#pragma unroll
      for (int d0 = 0; d0 < 4; ++d0) *(LAS bf16*)(stg + orow * 256 + (d0 * 32 + r32) * 2) = (bf16)(cvtpk(o[d0][r] * rli[r], 0.f) & 0xffffu); }
    asm volatile("s_waitcnt lgkmcnt(0)" ::: "memory");
    bf16* Ow = U.O + (size_t)(wid * 32) * U.ldo;
#pragma unroll
    for (int i = 0; i < 8; ++i) { const int row = i * 4 + (lane >> 4), ch = lane & 15; const u32x4 v = *(const LAS u32x4*)(stg + row * 256 + ch * 16); *(u32x4*)(Ow + (size_t)row * U.ldo + ch * 8) = v; }
  }
  asm volatile("s_waitcnt vmcnt(0) lgkmcnt(0)" ::: "memory");
  __syncthreads();
#undef SLOAD
#undef SWRITE
#undef SWAIT
#undef RESC
#undef MASKED
}
template <bool BAND, int SD> DI void attn_unit(const Unit& U, LAS char* lds, float C) {
  const int wid = __builtin_amdgcn_readfirstlane((int)threadIdx.x >> 6);
  if (wid < U.nact) attn_unit_<BAND, SD, true>(U, lds, C); else attn_unit_<BAND, SD, false>(U, lds, C);
}
}
#define XB_TMO      128
#define XB_XCNT(j)  (256  + 64 * (j))
#define XB_XSUB(j)  (1280 + 64 * (j))
#define XB_XGEN(j)  (2304 + 64 * (j))
#define XB_TOP      3328
#define XB_TOPGEN   3392
#define XCD_BAR_WORDS 3456
#define XB_SPIN_CAP (1u << 18)

__device__ __forceinline__ unsigned xb_ld(unsigned* p)              { return __hip_atomic_load(p, __ATOMIC_RELAXED, __HIP_MEMORY_SCOPE_AGENT); }
__device__ __forceinline__ unsigned xb_add(unsigned* p, unsigned v) { return __hip_atomic_fetch_add(p, v, __ATOMIC_RELAXED, __HIP_MEMORY_SCOPE_AGENT); }
__device__ __forceinline__ unsigned xb_xcc_id() { return (unsigned)__builtin_amdgcn_s_getreg((3 << 11) | 20) & 0xFu; }
#define XB_SPIN(cond, bar) do { unsigned _sp = 0; while (cond) { __builtin_amdgcn_s_sleep(1); \
    if ((++_sp & 255u) == 0u) { if (xb_ld(&(bar)[XB_TMO])) break; if (_sp > XB_SPIN_CAP) { atomicAdd(&(bar)[XB_TMO], 1u); break; } } } } while (0)

struct XcdBarrier {
    unsigned* bar; unsigned x;
    volatile LAS unsigned* st;
};

__device__ __forceinline__ XcdBarrier xcd_barrier_post(unsigned* bar, volatile LAS unsigned* st) {
    XcdBarrier b; b.bar = bar; b.x = xb_xcc_id(); b.st = st;
    if (threadIdx.x == 0) (void)xb_add(&bar[XB_XCNT(b.x)], 1u);
    return b;
}
__device__ __forceinline__ void xcd_barrier_complete(unsigned* bar, unsigned x, unsigned& nloc, unsigned& nx) {
    const unsigned G = gridDim.x * gridDim.y * gridDim.z;
    unsigned sum, cnt, mine, sp = 0u;
    for (;;) {
        sum = 0u; cnt = 0u; mine = 0u;
#pragma unroll
        for (unsigned j = 0; j < 16; ++j) { const unsigned c = xb_ld(&bar[XB_XCNT(j)]); sum += c; cnt += (c > 0u) ? 1u : 0u; mine = (j == x) ? c : mine; }
        if (sum == G) break;
        __builtin_amdgcn_s_sleep(1);
        if ((++sp & 255u) == 0u) { if (xb_ld(&bar[XB_TMO])) break; if (sp > XB_SPIN_CAP) { atomicAdd(&bar[XB_TMO], 1u); break; } }
    }
    nloc = mine > 0u ? mine : 1u; nx = cnt > 0u ? cnt : 1u;
}

__device__ __forceinline__ void xcd_barrier(const XcdBarrier& b) {
    asm volatile("s_waitcnt vmcnt(0)" ::: "memory");
    __syncthreads();
    if (threadIdx.x == 0) {
        unsigned* bar = b.bar;
        __builtin_amdgcn_s_waitcnt(0);
        unsigned nloc = b.st[0], nx = b.st[1];
        if (nloc == 0u) { xcd_barrier_complete(bar, b.x, nloc, nx); b.st[0] = nloc; b.st[1] = nx; }
        const unsigned old = xb_add(&bar[XB_XSUB(b.x)], 1u);
        const unsigned gen = old / nloc;
        if (old + 1u == (gen + 1u) * nloc) {
            __builtin_amdgcn_fence(__ATOMIC_RELEASE, "agent");
            asm volatile("s_waitcnt vmcnt(0)" ::: "memory");
            const unsigned og = xb_add(&bar[XB_TOP], 1u);
            const unsigned tg = og / nx;
            if (og + 1u == (tg + 1u) * nx) xb_add(&bar[XB_TOPGEN], 1u);
            else XB_SPIN(xb_ld(&bar[XB_TOPGEN]) == tg, bar);
            __builtin_amdgcn_fence(__ATOMIC_ACQUIRE, "agent");
            xb_add(&bar[XB_XGEN(b.x)], 1u);
            asm volatile("s_waitcnt vmcnt(0)" ::: "memory");
        } else {
            XB_SPIN(xb_ld(&bar[XB_XGEN(b.x)]) == gen, bar);
            __builtin_amdgcn_fence(__ATOMIC_ACQUIRE, "agent");
            asm volatile("s_waitcnt vmcnt(0)" ::: "memory");
        }
    }
    __syncthreads();
}

#ifndef PROBE_PH
#define PROBE_PH 0
#endif
#ifndef PROBE_REP
#define PROBE_REP 0
#endif
#ifndef PROBE_SYNC
#define PROBE_SYNC 0
#endif
#ifndef BAND_SD
#define BAND_SD 2
#endif
#ifndef MLA_SD
#define MLA_SD 1
#endif
constexpr int NSTEPS = 20;
struct Args { const float* in[23]; float* out; unsigned char* ws; int ph_lo, ph_hi; };
constexpr int LDS_BYTES = 133120 + 1024;

typedef const __attribute__((address_space(4))) Args CArgs;
DI const float* xin_row(CArgs& a, int row) { return row < NPR ? a.in[0] + (size_t)row * DM : a.in[1] + (size_t)(row - NPR) * DM; }

DI bool get_gemm(int ph, bool tail8, CArgs& a, const bf16*& A, int& lda, const bf16*& Bt, int& M, int& N, int& K, EpiMode& E) {
  unsigned char* ws = a.ws;
  E.mode = EM_BF16; E.O = nullptr; E.O2 = nullptr; E.ldc = 0; E.F = nullptr; E.outp = a.out; E.ws = ws; E.rs = (const float*)(ws + A_RSTD); lda = 0;
  switch (ph) {
    case 1:  A = (const bf16*)((const char*)a.out + 4096); lda = 4096; Bt = (const bf16*)(ws + W_QKV); M = MT; N = 6144; K = 2048; E.mode = EM_QKV; return true;
    case 3:  A = (const bf16*)(ws + A_O0);   Bt = (const bf16*)(ws + W_AO);  M = MT; N = 2048; K = 2048; E.O = (bf16*)(ws + A_T); E.ldc = 2048; if (tail8) { E.mode = EM_TAIL; E.O2 = (bf16*)(ws + A_Q0); } return true;
    case 5:  A = (const bf16*)((const char*)a.out + 4096); lda = 4096; Bt = (const bf16*)(ws + W_F1);  M = MT; N = 8192; K = 2048; E.mode = EM_RELU2; E.O = (bf16*)(ws + A_HID); E.ldc = 8192; return true;
    case 6:  A = (const bf16*)(ws + A_HID);  Bt = (const bf16*)(ws + W_F2);  M = MT; N = 2048; K = 8192; E.mode = tail8 ? EM_TAIL : EM_SPLIT; E.O = (bf16*)(ws + A_T); E.O2 = (bf16*)(ws + (tail8 ? A_PF : A_H)); E.ldc = 2048; return true;
    case 8:  A = (const bf16*)((const char*)a.out + 4096); lda = 4096; Bt = (const bf16*)(ws + W_D);   M = MT; N = 1280; K = 2048; E.mode = EM_F32; E.F = (float*)(ws + A_DQ); E.ldc = 1280; return true;
    case 10: A = (const bf16*)(ws + A_CQ);   Bt = (const bf16*)(ws + W_UQ);  M = MT; N = 3072; K = 512; E.mode = EM_QROPE; E.O = (bf16*)(ws + A_QM); E.ldc = 3072; return true;
    case 11: A = (const bf16*)(ws + A_CKVP); Bt = (const bf16*)(ws + W_UKV); M = NPR; N = 4096; K = 512; E.O = (bf16*)(ws + A_KNV); E.ldc = 4096; return true;
    case 13: A = (const bf16*)(ws + A_CKVS); Bt = (const bf16*)(ws + W_UKV); M = 33792; N = 4096; K = 512; E.O = (bf16*)(ws + A_KNV); E.ldc = 4096; return true;
    case 15: A = (const bf16*)(ws + A_O1);   Bt = (const bf16*)(ws + W_MO);  M = MT; N = 2048; K = 2048; E.O = (bf16*)(ws + A_T); E.ldc = 2048; if (tail8) { E.mode = EM_TAIL; E.O2 = (bf16*)(ws + A_QM); } return true;
    case 17: A = (const bf16*)((const char*)a.out + 4096); lda = 4096; Bt = (const bf16*)(ws + W_F1);  M = MT; N = 8192; K = 2048; E.mode = EM_RELU2; E.O = (bf16*)(ws + A_HID); E.ldc = 8192; return true;
    case 18: A = (const bf16*)(ws + A_HID);  Bt = (const bf16*)(ws + W_F2);  M = MT; N = 2048; K = 8192; E.mode = tail8 ? EM_TAIL : EM_SPLIT; E.O = (bf16*)(ws + A_T); E.O2 = (bf16*)(ws + (tail8 ? A_PF : A_H)); E.ldc = 2048; return true;
    default: return false;
  }
}

__global__ void __launch_bounds__(512) fwd_mega(Args a_) {
  extern __shared__ __attribute__((aligned(16))) unsigned char lds_raw[];
  LAS unsigned char* lds = (LAS unsigned char*)lds_raw;
  cg::grid_group grid = cg::this_grid();
  if (threadIdx.x < 2) ((volatile LAS unsigned*)(lds + 133120))[threadIdx.x] = 0u;
  __syncthreads();
  const XcdBarrier xbar = xcd_barrier_post((unsigned*)(a_.ws + A_BAR), (volatile LAS unsigned*)(lds + 133120));
  for (int it_ = a_.ph_lo; it_ < a_.ph_hi; ++it_) {
    const int ph = it_ <= PROBE_PH ? it_ : (it_ <= PROBE_PH + PROBE_REP ? PROBE_PH : it_ - PROBE_REP);
    const __attribute__((address_space(4))) char* kp_ = (const __attribute__((address_space(4))) char*)__builtin_amdgcn_kernarg_segment_ptr();
    asm volatile("" : "+s"(kp_));
    CArgs& a = *(CArgs*)kp_;
    int tid = threadIdx.x; asm volatile("" : "+v"(tid));
    const int lane = tid & 63, wave = __builtin_amdgcn_readfirstlane(tid >> 6);
    const int G = gridDim.x, gw = blockIdx.x * 8 + wave, NGW = G * 8;
    const size_t gt = (size_t)blockIdx.x * 512 + tid, NGT = (size_t)G * 512;
    unsigned char* ws = a.ws; float* outp = a.out;
    const bf16* gA; const bf16* gB; int gM, gN, gK; EpiMode E;
    const bool tail8 = (G == 256);
    int gLda;
    if (get_gemm(ph, tail8, a, gA, gLda, gB, gM, gN, gK, E)) {
#ifndef NO_GEMM
      run_gemm(lds, gA, gLda ? gLda : gK, gB, gM, gN, gK, E);
#endif
      if (ph == 1 || ph == 5 || ph == 8 || ph == 17) {
        const int nwg_ = (gM / 256) * (gN / 256), rem_ = nwg_ % G;
        int li_ = (int)blockIdx.x, nl_ = G;
        if (rem_ != 0) { li_ = (int)blockIdx.x - rem_; nl_ = li_ >= 0 ? G - rem_ : 0; }
        if (nl_ > 0) {
          LAS float* scr = (LAS float*)(lds + wave * 16640);
          const int w0 = li_ * 8 + wave, nw = nl_ * 8;
          if (ph == 1) {
            constexpr int I1 = 32 * 32, I2 = 32 * 8, I3 = 32 * 9, I4 = 8 * 48, I5 = 8 * 32, I6 = 8 * 32, I7 = 32 * 32, I8 = 32 * 128;
            constexpr int NIT = I1 + I2 + I3 + I4 + I5 + I6 + I7 + I8;
            for (int it = w0; it < NIT; it += nw) {
              int r = it;
              if (r < I1) { transpose_item<0>(a.in[11], 2048, 2048, (bf16*)(ws + W_AO), 0, scr, r, lane); continue; } r -= I1;
              if (r < I2) { transpose_item<0>(a.in[13], 2048, 512, (bf16*)(ws + W_D), 0, scr, r, lane, a.in[6] + DM); continue; } r -= I2;
              if (r < I3) { transpose_item<0>(a.in[16], 2048, 576, (bf16*)(ws + W_D), 512, scr, r, lane, a.in[6] + DM); continue; } r -= I3;
              if (r < I4) { transpose_item<1>(a.in[15], 512, 3072, (bf16*)(ws + W_UQ), 0, scr, r, lane); continue; } r -= I4;
              if (r < I5) { transpose_item<0>(a.in[18], 512, 2048, (bf16*)(ws + W_UKV), 0, scr, r, lane); continue; } r -= I5;
              if (r < I6) { transpose_item<0>(a.in[19], 512, 2048, (bf16*)(ws + W_UKV), 2048, scr, r, lane); continue; } r -= I6;
              if (r < I7) { transpose_item<0>(a.in[20], 2048, 2048, (bf16*)(ws + W_MO), 0, scr, r, lane); continue; } r -= I7;
              transpose_item<0>(a.in[21], 2048, 8192, (bf16*)(ws + W_F1), 0, scr, r, lane, a.in[8]);
            }
          } else if (ph == 5) {
            for (int it = w0; it < 128 * 32; it += nw) transpose_item<0>(a.in[22], 8192, 2048, (bf16*)(ws + W_F2), 0, scr, it, lane);
          } else if (ph == 8) {
            for (int it = w0; it < 32 * 128; it += nw) transpose_item<0>(a.in[21] + (size_t)2048 * 8192, 2048, 8192, (bf16*)(ws + W_F1), 0, scr, it, lane, a.in[8] + DM);
          } else {
            for (int it = w0; it < 128 * 32; it += nw) transpose_item<0>(a.in[22] + (size_t)2048 * 8192, 8192, 2048, (bf16*)(ws + W_F2), 0, scr, it, lane);
          }
        }
      }
    } else if (ph == 0 || ph == 7) {
      LAS float* scr = (LAS float*)(lds + wave * 16640);
      if (ph == 0) {
        for (int it = gw; it < 32 * 96; it += NGW) transpose_item<0>(a.in[10], 2048, 6144, (bf16*)(ws + W_QKV), 0, scr, it, lane, a.in[6]);
        { u32x4* z = (u32x4*)((bf16*)(ws + W_D) + (size_t)1088 * 2048); const size_t n16 = (size_t)192 * 2048 * 2 / 16;
          u32x4 zv = {0u, 0u, 0u, 0u}; asm volatile("" : "+v"(zv));
          for (size_t i = gt; i < n16; i += NGT) z[i] = zv; }
        { const size_t ng = (size_t)16 * 512 * 256;
#define CVT_A_LD(i, va, vb) const int isv##va = (i) >= ng; const size_t g##va = isv##va ? (i) - ng : (i); const float* s##va = a.in[isv##va ? 3 : 2] + g##va * 8; const f32x4 va = *(const f32x4*)s##va, vb = *(const f32x4*)(s##va + 4)
#define CVT_A_ST(va, vb) *(u32x4*)((bf16*)(ws + (isv##va ? A_VS : A_KS)) + (g##va / (512 * 256)) * 576 * 2048 + (g##va % (512 * 256)) * 8) = pack8(va, vb)
          size_t i = gt;
          for (; i + 3 * NGT < 2 * ng; i += 4 * NGT) { CVT_A_LD(i, p0, p1); CVT_A_LD(i + NGT, q0, q1); CVT_A_LD(i + 2 * NGT, r0, r1); CVT_A_LD(i + 3 * NGT, t0, t1);
            CVT_A_ST(p0, p1); CVT_A_ST(q0, q1); CVT_A_ST(r0, r1); CVT_A_ST(t0, t1); }
          for (; i < 2 * ng; i += NGT) { CVT_A_LD(i, p0, p1); CVT_A_ST(p0, p1); }
#undef CVT_A_LD
#undef CVT_A_ST
        }
        for (int m = gw; m < MT; m += NGW) row_x_prep(xin_row(a, m), xb_row(outp, m), (float*)(ws + A_RSTD) + m, lane);
      } else {
        for (int m = gw; m < MT; m += NGW)
          row_resid_norm<true, true>((const bf16*)(ws + A_T) + (size_t)m * DM, tail8 ? (const bf16*)(ws + A_PF) + (size_t)(m - NPR) * DM : (const bf16*)(ws + A_H) + (size_t)m * DM, tail8 ? (m < NPR ? 0 : 8) : 1, xb_row(outp, m), xb_row(outp, m), a.in[9], (float*)(ws + A_RSTD) + m, lane);
      }
    } else if (ph == 4) {
      for (int m = gw; m < MT; m += NGW)
        row_resid_norm<true, true>((const bf16*)(ws + A_T) + (size_t)m * DM, (const bf16*)(ws + A_Q0) + (size_t)(m - NPR) * DM, (tail8 && m >= NPR) ? 8 : 0, xb_row(outp, m), xb_row(outp, m), a.in[7], (float*)(ws + A_RSTD) + m, lane);
    } else if (ph == 16) {
      for (int m = gw; m < MT; m += NGW)
        row_resid_norm<true, true>((const bf16*)(ws + A_T) + (size_t)m * DM, (const bf16*)(ws + A_QM) + (size_t)(m - NPR) * DM, (tail8 && m >= NPR) ? 8 : 0, xb_row(outp, m), xb_row(outp, m), a.in[7] + DM, (float*)(ws + A_RSTD) + m, lane);
    } else if (ph == 19) {
      for (int m = gw; m < MT; m += NGW)
        row_resid_norm<true, false>((const bf16*)(ws + A_T) + (size_t)m * DM, tail8 ? (const bf16*)(ws + A_PF) + (size_t)(m - NPR) * DM : (const bf16*)(ws + A_H) + (size_t)m * DM, tail8 ? (m < NPR ? 0 : 8) : 1, xb_row(outp, m), outp + (size_t)m * DM, a.in[9] + DM, nullptr, lane);
    } else if (ph == 9) {
      for (int m = gw; m < MT; m += NGW) row_mla((const bf16*)(ws + A_DQ) + (size_t)m * 1280, m, a.in[14], a.in[17], ws, outp, lane);
      { const size_t ng = (size_t)16 * 2048 * 64;
#define CVT_C_LD(i, va, vb) const size_t g##va = (i); const float* s##va = a.in[4] + g##va * 8; const f32x4 va = *(const f32x4*)s##va, vb = *(const f32x4*)(s##va + 4)
#define CVT_C_ST(va, vb) *(u32x4*)((bf16*)(ws + A_CKVS) + (g##va / (2048 * 64)) * 2112 * 512 + (g##va % (2048 * 64)) * 8) = pack8(va, vb)
        size_t i = gt;
        for (; i + 3 * NGT < ng; i += 4 * NGT) { CVT_C_LD(i, p0, p1); CVT_C_LD(i + NGT, q0, q1); CVT_C_LD(i + 2 * NGT, r0, r1); CVT_C_LD(i + 3 * NGT, t0, t1);
          CVT_C_ST(p0, p1); CVT_C_ST(q0, q1); CVT_C_ST(r0, r1); CVT_C_ST(t0, t1); }
        for (; i < ng; i += NGT) { CVT_C_LD(i, p0, p1); CVT_C_ST(p0, p1); }
#undef CVT_C_LD
#undef CVT_C_ST
      }
      { const size_t ng = (size_t)16 * 2048 * 8;
        for (size_t i = gt; i < ng; i += NGT) { const size_t rowi = i >> 3; const int q = (int)(i & 7); const size_t b = rowi / 2048, r = rowi % 2048;
          const float* src = a.in[5] + rowi * 64 + 4 * q; const f32x4 x1 = *(const f32x4*)src, x2 = *(const f32x4*)(src + 32);
          u32x4 w; w.x = cvtpk(x1.x, x2.x); w.y = cvtpk(x1.y, x2.y); w.z = cvtpk(x1.z, x2.z); w.w = cvtpk(x1.w, x2.w);
          *(u32x4*)((bf16*)(ws + A_KRS) + (b * 2112 + r) * 64 + 8 * q) = w; } }
    } else if (ph == 2) {
      const float C = 0.08838834764831845f * LOG2E;
      for (int u = blockIdx.x; u < 1280; u += G) {
        att::Unit U; U.Qr = nullptr; U.KR = nullptr; U.ldq = 2048; U.ldk = 2048; U.ldo = 2048;
        U.fillb = (u == (int)blockIdx.x) || (G % 16 != 0);
        if (u < 1024) { const int h = u & 15, qb = (u >> 4) & 15, b = u >> 8, c0 = qb * 4, kc0 = c0 > 8 ? c0 - 8 : 0;
          const size_t rq = (size_t)b * 4096 + qb * 256, rk = (size_t)b * 4096 + kc0 * 64;
          U.Q = (const bf16*)(ws + A_Q0) + rq * 2048 + h * 128; U.K = (const bf16*)(ws + A_KP) + rk * 2048 + h * 128; U.V = (const bf16*)(ws + A_VP) + rk * 2048 + h * 128;
          U.O = (bf16*)(ws + A_O0) + rq * 2048 + h * 128; U.nt = c0 + 4 - kc0; U.nact = 8; U.thi0 = c0 - kc0; U.tlo0 = c0 - 8 - kc0; U.qrel0 = (c0 - kc0) * 64; U.bias = a.in[12] + h * 513;
        } else { const int us = u - 1024, h = us & 15, b = us >> 4; const size_t rq = (size_t)NPR + b * 64;
          U.Q = (const bf16*)(ws + A_Q0) + rq * 2048 + h * 128; U.K = (const bf16*)(ws + A_KS) + (size_t)b * 576 * 2048 + h * 128; U.V = (const bf16*)(ws + A_VS) + (size_t)b * 576 * 2048 + h * 128;
          U.O = (bf16*)(ws + A_O0) + rq * 2048 + h * 128; U.nt = 9; U.nact = 2; U.thi0 = 8; U.tlo0 = 0; U.qrel0 = 512; U.bias = a.in[12] + h * 513; }
#ifndef NO_BAND
        att::attn_unit<true, BAND_SD>(U, (LAS char*)lds, C);
#endif
      }
    } else if (ph == 12 || ph == 14) {
      const float C = 0.07216878364870322f * LOG2E;
      const int nunits = ph == 12 ? 1024 : 256;
      for (int i = blockIdx.x; i < nunits; i += G) {
        att::Unit U; U.ldq = 3072; U.ldk = 4096; U.ldo = 2048; U.bias = nullptr; U.qrel0 = 0; U.tlo0 = -100000; U.fillb = 0;
        if (ph == 12) { const int rnd = i >> 8, v = i & 255, bh = v >> 2, s = v & 3, qb = rnd == 0 ? s : rnd == 1 ? 7 - s : rnd == 2 ? 8 + s : 15 - s, b = bh >> 4, h = bh & 15;
          const size_t rq = (size_t)b * 4096 + qb * 256, rk = (size_t)b * 4096;
          U.Q = (const bf16*)(ws + A_QM) + rq * 3072 + h * 128; U.Qr = (const bf16*)(ws + A_QM) + rq * 3072 + 2048 + h * 64;
          U.K = (const bf16*)(ws + A_KNV) + rk * 4096 + h * 128; U.V = (const bf16*)(ws + A_KNV) + rk * 4096 + 2048 + h * 128; U.KR = (const bf16*)(ws + A_KRP) + rk * 64;
          U.O = (bf16*)(ws + A_O1) + rq * 2048 + h * 128; U.nt = qb * 4 + 4; U.nact = 8; U.thi0 = qb * 4;
        } else { const int b = i >> 4, h = i & 15; const size_t rq = (size_t)NPR + b * 64, rk = (size_t)b * 2112;
          U.Q = (const bf16*)(ws + A_QM) + rq * 3072 + h * 128; U.Qr = (const bf16*)(ws + A_QM) + rq * 3072 + 2048 + h * 64;
          U.K = (const bf16*)(ws + A_KNV) + rk * 4096 + h * 128; U.V = (const bf16*)(ws + A_KNV) + rk * 4096 + 2048 + h * 128; U.KR = (const bf16*)(ws + A_KRS) + rk * 64;
          U.O = (bf16*)(ws + A_O1) + rq * 2048 + h * 128; U.nt = 33; U.nact = 2; U.thi0 = 32; }
#ifndef NO_MLA
        att::attn_unit<false, MLA_SD>(U, (LAS char*)lds, C);
#endif
      }
    }
    if (it_ + 1 < a_.ph_hi && ph != 10) { if (a_.ph_hi > 1000) grid.sync(); else xcd_barrier(xbar);
      for (int e_ = 0; e_ < PROBE_SYNC; ++e_) xcd_barrier(xbar); }
  }
}

#ifndef MULTI_LAUNCH
#define MULTI_LAUNCH 0
#endif
extern "C" void kernel_launch(void* const* d_in, const int* in_sizes, int n_in, void* d_out, int out_size, void* d_ws, size_t ws_size, hipStream_t stream) {
  static int grid = 0;
  if (grid == 0) {
    if (n_in != 23 || out_size != (int)O_END || ws_size < WS_NEED) { fprintf(stderr, "kernel_launch: unexpected shapes n_in %d out %d ws %zu (need %zu)\n", n_in, out_size, ws_size, (size_t)WS_NEED); grid = -1; return; }
    int dev = 0, cus = 0, per_cu = 0;
    hipGetDevice(&dev); hipDeviceGetAttribute(&cus, hipDeviceAttributeMultiprocessorCount, dev);
    if (hipFuncSetAttribute((const void*)fwd_mega, hipFuncAttributeMaxDynamicSharedMemorySize, LDS_BYTES) != hipSuccess) { fprintf(stderr, "hipFuncSetAttribute failed\n"); grid = -1; return; }
    hipOccupancyMaxActiveBlocksPerMultiprocessor(&per_cu, (const void*)fwd_mega, 512, LDS_BYTES);
    (void)hipGetLastError();
    if (per_cu < 1) per_cu = 1;
    grid = cus;
  }
  if (grid < 0) return;
  if (hipMemsetAsync((char*)d_ws + A_BAR, 0, 16384, stream) != hipSuccess) { fprintf(stderr, "memset failed\n"); return; }
  Args a{};
  for (int i = 0; i < 23; ++i) a.in[i] = (const float*)d_in[i];
  a.out = (float*)d_out; a.ws = (unsigned char*)d_ws;
#if MULTI_LAUNCH
  for (int ph = 0; ph < NSTEPS; ++ph) { a.ph_lo = ph; a.ph_hi = ph + 1; hipLaunchKernelGGL(fwd_mega, dim3(grid), dim3(512), LDS_BYTES, stream, a); }
#else
  a.ph_lo = 0; a.ph_hi = NSTEPS + PROBE_REP;
  void* args[] = {&a};
  hipError_t e = hipLaunchCooperativeKernel((const void*)fwd_mega, dim3(grid), dim3(512), args, LDS_BYTES, stream);
  if (e != hipSuccess) fprintf(stderr, "cooperative launch failed: %s (grid %d)\n", hipGetErrorString(e), grid);
#endif
}
```

```cpp
#include <hip/hip_runtime.h>
#include <hip/hip_cooperative_groups.h>
#include <cstdio>
#include <cstdint>
namespace cg = cooperative_groups;
namespace pg8 {
#define PG8_LAS __attribute__((address_space(3)))
typedef unsigned short bf16_t;
typedef short bf16x8 __attribute__((ext_vector_type(8)));
typedef float f32x4 __attribute__((ext_vector_type(4)));
typedef unsigned u32x4 __attribute__((ext_vector_type(4)));
constexpr int BM = 256, BK = 64, HALF = 128, HTB = HALF * BK * 2  , STAGE_BYTES = 8 * HTB, NXCD = 8, WGM = 8;

__host__ __device__ __forceinline__ int lds_byte(int r, int c) { const int st = (r >> 4) * 2 + (c >> 5), rr = r & 15, cc = c & 31, ob = rr * 64 + cc * 2; return st * 1024 + (ob ^ (((ob >> 9) & 1) << 5)); }
__host__ __device__ __forceinline__ void stage_rc(int b, int& R, int& C) { const int st = b / 1024, sb = b % 1024, swz = sb ^ (((sb >> 9) & 1) << 5); R = (st >> 1) * 16 + swz / 64; C = (st & 1) * 32 + (swz % 64) / 2; }
__host__ __device__ __forceinline__ int perm32(int rho) { const int n = rho >> 4, i = rho & 15; return 8 * (i >> 2) + 4 * n + (i & 3); }

struct Unit { int pm, pn, kb, nk, part; };
struct Gemm { const bf16_t* A; const bf16_t* Bt; int M, N, K, lda; };

struct StaticOrder {
    int nM, nN, nwg, G, c, KT, ns;
    __host__ __device__ __forceinline__ void init(int M, int N, int K, int G_, int c_, int ns_) { nM = M / BM; nN = N / BM; nwg = nM * nN; G = G_; c = c_; KT = K / BK; ns = ns_; }
    __host__ __device__ __forceinline__ bool next(int i, Unit& uo) const {
        if (ns == 8) {
            const int L = i * G + c; Unit u;
            if (L < 512) {
                int wgid = L; { const int q = 512 / NXCD, xcd = wgid % NXCD, off = wgid / NXCD; wgid = xcd * q + off; }
                const int nig = WGM * nN; const int gid = wgid / nig, fm = gid * WGM;
                u.pm = fm + ((wgid % nig) / nN); u.pn = (wgid % nig) % nN; u.kb = 0; u.nk = KT; u.part = 2;
            } else {
                const int q = L - 512, t = q % 32, kp = q / 32;
                u.pm = 64 + t / 8; u.pn = t % 8; u.nk = KT / 8; u.kb = kp * u.nk; u.part = 16 + kp;
            }
            uo = u; return L < 768;
        }
        const int np = nwg * ns;
        const int L = i * G + c; const bool ok = L < np;
        int wgid = L; { const int q = np / NXCD, r = np % NXCD, xcd = wgid % NXCD, off = wgid / NXCD; wgid = (xcd < r ? xcd * (q + 1) : r * (q + 1) + (xcd - r) * q) + off; }
        const int half = wgid >= nwg ? 1 : 0; wgid -= half * nwg;
        const int nig = WGM * nN, gid = wgid / nig, fm = gid * WGM, gsz = (nM - fm) < WGM ? (nM - fm) : WGM;
        Unit u; u.pm = fm + ((wgid % nig) % gsz); u.pn = (wgid % nig) / gsz; u.nk = KT / ns; u.kb = half * u.nk; u.part = ns == 2 ? half : 2;
        uo = u; return ok;
    }
    __device__ __forceinline__ void a_ready(const Unit&) const {}
    __device__ __forceinline__ void done(const Unit&) const {}
};
__device__ __forceinline__ unsigned cvt_pk_bf16(float lo, float hi) { unsigned r; asm volatile("v_cvt_pk_bf16_f32 %0, %1, %2" : "=v"(r) : "v"(lo), "v"(hi)); return r; }
template <class Epi, class Sched, bool ALIGN_EPI = false, bool SP2 = false>
__device__ __forceinline__ void gemm_phase(PG8_LAS unsigned char* lds, const Gemm g, const Sched& S, const Epi& E) {
    int tid = threadIdx.x; asm volatile("" : "+v"(tid)); const int wid = __builtin_amdgcn_readfirstlane(tid >> 6), lane = tid & 63, wr = wid >> 2, wc = wid & 3, fr = lane & 15, fq = lane >> 4;
    const int K = g.K;
    unsigned voffA[2], voffB[2];
#pragma unroll
    for (int i = 0; i < 2; ++i) { int R, C; stage_rc(tid * 16 + i * 8192, R, C); const int Rb = Epi::PERM ? ((R & ~31) + perm32(R & 31)) : R;
        voffA[i] = (unsigned)(R * g.lda + C) * 2u; voffB[i] = (unsigned)(Rb * K + C) * 2u; }
    const size_t kstep = (size_t)(BK * 2);
    const size_t hstep = (size_t)HALF * K * 2;
    const size_t tstep = 2 * hstep;
    const size_t hstepA = (size_t)HALF * g.lda * 2, tstepA = 2 * hstepA;
    const unsigned ldsw = (unsigned)wid * 1024u;
    const int aoff = lds_byte(wr * 64 + fr, fq * 8), boff = lds_byte(wc * 32 + fr, fq * 8);
#define PG8_SA(b, h) (((b) * 2 + (h)) * HTB)
#define PG8_SB(b, h) ((4 + (b) * 2 + (h)) * HTB)
#define PG8_STAGE(bufoff, gbase, voff) do { _Pragma("unroll") for (int _i = 0; _i < 2; ++_i) \
        __builtin_amdgcn_global_load_lds((const unsigned*)((const char*)(gbase) + (voff)[_i]), (PG8_LAS unsigned*)(lds + (bufoff) + ldsw + _i * 8192), 16, 0, 0); } while (0)
#define PG8_LDA(dst, b, h) do { _Pragma("unroll") for (int m = 0; m < 4; ++m) _Pragma("unroll") for (int k = 0; k < 2; ++k) dst[m][k] = *(const PG8_LAS bf16x8*)(lds + PG8_SA(b, h) + aoff + m * 2048 + k * 1024); } while (0)
#define PG8_LDB(dst, b, h) do { _Pragma("unroll") for (int n = 0; n < 2; ++n) _Pragma("unroll") for (int k = 0; k < 2; ++k) dst[n][k] = *(const PG8_LAS bf16x8*)(lds + PG8_SB(b, h) + boff + n * 2048 + k * 1024); } while (0)
#define PG8_MMA(ai, bj, At, Bt) do { __builtin_amdgcn_s_setprio(1); _Pragma("unroll") for (int m = 0; m < 4; ++m) _Pragma("unroll") for (int n = 0; n < 2; ++n) _Pragma("unroll") for (int k = 0; k < 2; ++k) \
        acc[ai][bj][m][n] = __builtin_amdgcn_mfma_f32_16x16x32_bf16(Bt[n][k], At[m][k], acc[ai][bj][m][n], 0, 0, 0); __builtin_amdgcn_s_setprio(0); } while (0)
#define PG8_WAIT_V(n) asm volatile("s_waitcnt vmcnt(" #n ")" ::: "memory")
#define PG8_WAIT_L(n) asm volatile("s_waitcnt lgkmcnt(" #n ")" ::: "memory")
#define PG8_BAR __builtin_amdgcn_s_barrier()
#define PG8_SCHED __builtin_amdgcn_sched_barrier(0)
    Unit cur, nxt; int ui = 0;
    if (!S.next(0, cur)) return;
    f32x4 acc[2][2][4][2];
#pragma unroll
    for (int a = 0; a < 2; ++a)
#pragma unroll
        for (int b = 0; b < 2; ++b)
#pragma unroll
            for (int m = 0; m < 4; ++m)
#pragma unroll
                for (int n = 0; n < 2; ++n) acc[a][b][m][n] = (f32x4){0.f, 0.f, 0.f, 0.f};
    bf16x8 At[4][2], B0[2][2], B1[2][2];
    const char* cA = (const char*)g.A + (size_t)cur.pm * tstepA + (size_t)cur.kb * kstep; const char* cB = (const char*)g.Bt + (size_t)cur.pn * tstep + (size_t)cur.kb * kstep;
    S.a_ready(cur);
    if constexpr (SP2) {
        PG8_STAGE(PG8_SB(0, 0), cB, voffB); PG8_STAGE(PG8_SB(0, 1), cB + hstep, voffB); PG8_STAGE(PG8_SA(0, 0), cA, voffA); PG8_STAGE(PG8_SA(0, 1), cA + hstepA, voffA);
        if (wr == 1) PG8_BAR;
        PG8_WAIT_V(2); PG8_BAR;
        PG8_STAGE(PG8_SB(1, 0), cB + kstep, voffB); PG8_STAGE(PG8_SA(1, 0), cA + kstep, voffA); PG8_STAGE(PG8_SB(1, 1), cB + hstep + kstep, voffB);
        PG8_WAIT_V(6); PG8_BAR;
    } else {
        PG8_STAGE(PG8_SB(0, 0), cB, voffB); PG8_STAGE(PG8_SA(0, 0), cA, voffA); PG8_STAGE(PG8_SB(0, 1), cB + hstep, voffB); PG8_STAGE(PG8_SA(0, 1), cA + hstepA, voffA);
        if (wr == 1) PG8_BAR;
        PG8_WAIT_V(4); PG8_BAR;
        PG8_STAGE(PG8_SB(1, 0), cB + kstep, voffB); PG8_STAGE(PG8_SA(1, 0), cA + kstep, voffA); PG8_STAGE(PG8_SB(1, 1), cB + hstep + kstep, voffB);
        PG8_WAIT_V(6); PG8_BAR;
    }
    for (;;) {
        const bool has_next = S.next(ui + 1, nxt);
        const char* nA = has_next ? (const char*)g.A + (size_t)nxt.pm * tstepA + (size_t)nxt.kb * kstep : cA; const char* nB = has_next ? (const char*)g.Bt + (size_t)nxt.pn * tstep + (size_t)nxt.kb * kstep : cB;
        const int nt = cur.nk;
        for (int t = 0; t < nt; t += 2) {
            const bool last = (t == nt - 2);
            const char* a1 = cA + (size_t)(t + 1) * kstep;
            const char* a2 = last ? nA : cA + (size_t)(t + 2) * kstep; const char* b2 = last ? nB : cB + (size_t)(t + 2) * kstep;
            const char* a3 = a2 + kstep; const char* b3 = b2 + kstep;
            if (last && has_next) S.a_ready(nxt);
            if constexpr (SP2) {
            PG8_LDB(B0, 0, 0); PG8_LDB(B1, 0, 1); PG8_SCHED; PG8_LDA(At, 0, 0); PG8_STAGE(PG8_SA(1, 1), a1 + hstepA, voffA);
            PG8_WAIT_V(8); PG8_WAIT_L(0); PG8_BAR; PG8_MMA(0, 0, At, B0); PG8_MMA(0, 1, At, B1); PG8_BAR; PG8_SCHED;
            PG8_LDA(At, 0, 1); PG8_STAGE(PG8_SB(0, 0), b2, voffB); PG8_STAGE(PG8_SB(0, 1), b2 + hstep, voffB); PG8_STAGE(PG8_SA(0, 0), a2, voffA);
            PG8_WAIT_V(8); PG8_WAIT_L(0); PG8_BAR; PG8_MMA(1, 0, At, B0); PG8_MMA(1, 1, At, B1); PG8_BAR; PG8_SCHED;
            PG8_LDB(B0, 1, 0); PG8_LDB(B1, 1, 1); PG8_SCHED; PG8_LDA(At, 1, 0); PG8_STAGE(PG8_SA(0, 1), a2 + hstepA, voffA);
            PG8_WAIT_V(8); PG8_WAIT_L(0); PG8_BAR; PG8_MMA(0, 0, At, B0); PG8_MMA(0, 1, At, B1); PG8_BAR; PG8_SCHED;
            PG8_LDA(At, 1, 1); PG8_STAGE(PG8_SB(1, 0), b3, voffB); PG8_STAGE(PG8_SB(1, 1), b3 + hstep, voffB); PG8_STAGE(PG8_SA(1, 0), a3, voffA);
            PG8_WAIT_V(8); PG8_WAIT_L(0); PG8_BAR; PG8_MMA(1, 0, At, B0); PG8_MMA(1, 1, At, B1); PG8_BAR; PG8_SCHED;
            } else {
            PG8_LDB(B0, 0, 0); PG8_SCHED; PG8_LDA(At, 0, 0); PG8_STAGE(PG8_SA(1, 1), a1 + hstepA, voffA);
            PG8_WAIT_L(8); PG8_BAR; PG8_WAIT_L(0); PG8_MMA(0, 0, At, B0); PG8_BAR; PG8_SCHED;
            PG8_LDB(B1, 0, 1); PG8_STAGE(PG8_SB(0, 0), b2, voffB);
            PG8_BAR; PG8_WAIT_L(0); PG8_MMA(0, 1, At, B1); PG8_BAR;
            PG8_LDA(At, 0, 1); PG8_STAGE(PG8_SA(0, 0), a2, voffA);
            PG8_BAR; PG8_WAIT_L(0); PG8_MMA(1, 0, At, B0); PG8_BAR; PG8_SCHED;
            PG8_STAGE(PG8_SB(0, 1), b2 + hstep, voffB);
            PG8_WAIT_V(6); PG8_BAR; PG8_MMA(1, 1, At, B1); PG8_BAR;
            PG8_LDB(B0, 1, 0); PG8_SCHED; PG8_LDA(At, 1, 0); PG8_STAGE(PG8_SA(0, 1), a2 + hstepA, voffA);
            PG8_WAIT_L(8); PG8_BAR; PG8_WAIT_L(0); PG8_MMA(0, 0, At, B0); PG8_BAR; PG8_SCHED;
            PG8_LDB(B1, 1, 1); PG8_STAGE(PG8_SB(1, 0), b3, voffB);
            PG8_BAR; PG8_WAIT_L(0); PG8_MMA(0, 1, At, B1); PG8_BAR;
            PG8_LDA(At, 1, 1); PG8_STAGE(PG8_SA(1, 0), a3, voffA);
            PG8_BAR; PG8_WAIT_L(0); PG8_MMA(1, 0, At, B0); PG8_BAR; PG8_SCHED;
            PG8_STAGE(PG8_SB(1, 1), b3 + hstep, voffB);
            PG8_WAIT_V(6); PG8_BAR; PG8_MMA(1, 1, At, B1); PG8_BAR;
            }
        }
        if constexpr (ALIGN_EPI) { if (wr == 0) PG8_BAR; }
        if constexpr (!Epi::AFTER_DRAIN) { E(acc, cur, wr, wc, fr, fq); S.done(cur); }
        if (!has_next) break;
#pragma unroll
        for (int a = 0; a < 2; ++a)
#pragma unroll
            for (int b = 0; b < 2; ++b)
#pragma unroll
                for (int m = 0; m < 4; ++m)
#pragma unroll
                    for (int n = 0; n < 2; ++n) acc[a][b][m][n] = (f32x4){0.f, 0.f, 0.f, 0.f};
        cur = nxt; cA = nA; cB = nB; ++ui;
        if constexpr (ALIGN_EPI) { if (wr == 1) PG8_BAR; }
    }
    PG8_WAIT_V(0);
    if constexpr (!ALIGN_EPI) { if (wr == 0) PG8_BAR; }
    PG8_BAR;
    if constexpr (Epi::AFTER_DRAIN) { E.fused(acc, cur, wr, wc, fr, fq, lds, wid, lane); S.done(cur); }
#undef PG8_SA
#undef PG8_SB
#undef PG8_STAGE
#undef PG8_LDA
#undef PG8_LDB
#undef PG8_MMA
#undef PG8_WAIT_V
#undef PG8_WAIT_L
#undef PG8_BAR
#undef PG8_SCHED
}
}
#define LAS __attribute__((address_space(3)))
#define DI __device__ __forceinline__
typedef unsigned short bf16;
typedef float f32x4 __attribute__((ext_vector_type(4)));
typedef float f32x8 __attribute__((ext_vector_type(8)));
typedef float f32x16 __attribute__((ext_vector_type(16)));
typedef short bf16x8 __attribute__((ext_vector_type(8)));
typedef short s16x4 __attribute__((ext_vector_type(4)));
typedef unsigned u32x4 __attribute__((ext_vector_type(4)));
typedef unsigned u32x2 __attribute__((ext_vector_type(2)));

constexpr int DM = 2048, NPR = 16384, NSA = 1024, MT = NPR + NSA, SEQ = 4096, DEC = 64, PAST = 2048, DFF = 8192;
constexpr float EPS = 1e-6f;
constexpr float LOG2E = 1.4426950408889634f;

constexpr size_t O_Y = 0, O_AKP = 35651584, O_AVP = 39845888, O_AKS = 44040192, O_AVS = 46137344,
                 O_CKVP = 48234496, O_KRP = 56623104, O_CKVS = 57671680, O_KRS = 58195968, O_END = 58261504;
constexpr size_t MiB = 1u << 20;
constexpr size_t W_QKV = 0, W_AO = 24 * MiB, W_D = 32 * MiB, W_UQ = 37 * MiB, W_UKV = 40 * MiB, W_MO = 44 * MiB, W_F1 = 52 * MiB, W_F2 = 84 * MiB;
constexpr size_t A_H = 116 * MiB, A_T = 184 * MiB, A_R = 252 * MiB;
constexpr size_t A_Q0 = A_R, A_KP = A_R + 68 * MiB, A_VP = A_KP + 64 * MiB, A_KS = A_VP + 64 * MiB, A_VS = A_KS + 36 * MiB, A_O0 = A_VS + 36 * MiB;
constexpr size_t A_PF = 528 * MiB;
constexpr size_t A_HID = A_R;
constexpr size_t A_CKVP = A_R, A_CKVS = A_R + 16 * MiB, A_KRP = A_CKVS + 33 * MiB, A_KRS = A_KRP + 2 * MiB, A_QM = A_KRS + 5 * MiB, A_KNV = A_QM + 102 * MiB;
constexpr size_t A_DQ = A_KNV, A_CQ = A_KNV + 130 * MiB, A_O1 = A_H;
constexpr size_t A_BAR = A_KNV + 264 * MiB;
constexpr size_t A_RSTD = A_BAR + 65536;
constexpr size_t WS_NEED = A_RSTD + 131072;

DI unsigned cvtpk(float lo, float hi) { unsigned r; asm volatile("v_cvt_pk_bf16_f32 %0, %1, %2" : "=v"(r) : "v"(lo), "v"(hi)); return r; }
DI float bflo(unsigned w) { return __uint_as_float(w << 16); }
DI float bfhi(unsigned w) { return __uint_as_float(w & 0xffff0000u); }
DI float wave_sum(float v) {
  v += __int_as_float(__builtin_amdgcn_ds_swizzle(__float_as_int(v), (1 << 10) | 0x1f));
  v += __int_as_float(__builtin_amdgcn_ds_swizzle(__float_as_int(v), (2 << 10) | 0x1f));
  v += __int_as_float(__builtin_amdgcn_ds_swizzle(__float_as_int(v), (4 << 10) | 0x1f));
  v += __int_as_float(__builtin_amdgcn_ds_swizzle(__float_as_int(v), (8 << 10) | 0x1f));
  v += __int_as_float(__builtin_amdgcn_ds_swizzle(__float_as_int(v), (16 << 10) | 0x1f));
  auto rr = __builtin_amdgcn_permlane32_swap(__float_as_uint(v), __float_as_uint(v), false, false);
  return __uint_as_float(rr[0]) + __uint_as_float(rr[1]);
}
DI u32x4 pack8(f32x4 a, f32x4 b) { u32x4 w; w.x = cvtpk(a.x, a.y); w.y = cvtpk(a.z, a.w); w.z = cvtpk(b.x, b.y); w.w = cvtpk(b.z, b.w); return w; }


DI void sincos_cw(float x, float& sn, float& cs) {
  const float k = rintf(x * 0.63661977236758134f);
  float r = fmaf(-k, 1.5703125f, x); r = fmaf(-k, 4.837512969970703125e-4f, r); r = fmaf(-k, 7.54978995489188216e-8f, r);
  const float z = r * r;
  const float sp = fmaf(r * z, fmaf(z, fmaf(z, -1.9515295891e-4f, 8.3321608736e-3f), -1.6666654611e-1f), r);
  const float cp = fmaf(z * z, fmaf(z, fmaf(z, 2.443315711809948e-5f, -1.388731625493765e-3f), 4.166664568298827e-2f), fmaf(z, -0.5f, 1.0f));
  const int q = ((int)k) & 3;
  const float s1 = (q & 1) ? cp : sp, c1 = (q & 1) ? sp : cp;
  sn = (q & 2) ? -s1 : s1; cs = ((q + 1) & 2) ? -c1 : c1;
}
enum { EM_BF16 = 0, EM_QKV = 1, EM_RELU2 = 2, EM_F32 = 3, EM_QROPE = 4, EM_SPLIT = 5, EM_TAIL = 6 };
struct EpiMode {
  static constexpr bool PERM = true, AFTER_DRAIN = false;
  int mode; bf16* O; int ldc; float* F; float* outp;
  bf16* O2;
  const float* rs;
  unsigned char* ws;
  template <int MODE> DI void store8(int row, int col, f32x4 v0, f32x4 v1, int part) const {
    if (MODE == EM_QKV || MODE == EM_RELU2 || MODE == EM_F32) { const float r_ = rs[row]; v0 *= r_; v1 *= r_; }
    if (MODE == EM_TAIL) {
      if (part >= 16) *(u32x4*)(O2 + ((size_t)(part - 16) * 1024 + (row - NPR)) * 2048 + col) = pack8(v0, v1);
      else *(u32x4*)(O + (size_t)row * ldc + col) = pack8(v0, v1);
    } else if (MODE == EM_SPLIT) {
      bf16* d = (part & 1) ? O2 : O; *(u32x4*)(d + (size_t)row * ldc + col) = pack8(v0, v1);
      if (part & 2) *(u32x4*)(O2 + (size_t)row * ldc + col) = (u32x4){0u, 0u, 0u, 0u};
    } else if (MODE == EM_BF16) { *(u32x4*)(O + (size_t)row * ldc + col) = pack8(v0, v1); }
    else if (MODE == EM_RELU2) {
      f32x4 a = __builtin_elementwise_max(v0, (f32x4){0.f, 0.f, 0.f, 0.f}), b = __builtin_elementwise_max(v1, (f32x4){0.f, 0.f, 0.f, 0.f});
      *(u32x4*)(O + (size_t)row * ldc + col) = pack8(a * a, b * b); }
    else if (MODE == EM_F32) { if (col < 1088) *(u32x4*)((bf16*)F + (size_t)row * ldc + col) = pack8(v0, v1); }
    else if (MODE == EM_QKV) {
      const u32x4 w = pack8(v0, v1);
      if (col < 2048) { *(u32x4*)((bf16*)(ws + A_Q0) + (size_t)row * 2048 + col) = w; }
      else {
        const int isv = col >= 4096; const int c = col - (isv ? 4096 : 2048);
        if (row < NPR) {
          *(u32x4*)((bf16*)(ws + (isv ? A_VP : A_KP)) + (size_t)row * 2048 + c) = w;
          const int s = row & 4095, b = row >> 12;
          if (s >= 3584) { float* p = outp + (isv ? O_AVP : O_AKP) + ((size_t)(b * 512 + s - 3584)) * 2048 + c; *(f32x4*)p = v0; *(f32x4*)(p + 4) = v1; }
        } else {
          const int rs = row - NPR, b = rs >> 6, i = rs & 63;
          *(u32x4*)((bf16*)(ws + (isv ? A_VS : A_KS)) + ((size_t)(b * 576 + 512 + i)) * 2048 + c) = w;
          float* p = outp + (isv ? O_AVS : O_AKS) + (size_t)rs * 2048 + c; *(f32x4*)p = v0; *(f32x4*)(p + 4) = v1;
        }
      }
    } else if (MODE == EM_QROPE) {
      if (col >= 2048) {
        const int j = col - 2048, i0 = (j & 63) >> 1;
        const float pos = (float)(row < NPR ? (row & 4095) : PAST + ((row - NPR) & 63));
        float x[8] = {v0.x, v0.y, v0.z, v0.w, v1.x, v1.y, v1.z, v1.w};
#pragma unroll
        for (int p = 0; p < 4; ++p) {
          const float inv = exp2f(-(float)(i0 + p) * 0.41524101186092029f);
          float sn, cs; sincos_cw(pos * inv, sn, cs);
          const float a = x[2 * p], b = x[2 * p + 1];
          x[2 * p] = a * cs - b * sn; x[2 * p + 1] = b * cs + a * sn;
        }
        v0 = (f32x4){x[0], x[1], x[2], x[3]}; v1 = (f32x4){x[4], x[5], x[6], x[7]};
      }
      *(u32x4*)(O + (size_t)row * ldc + col) = pack8(v0, v1);
    }
  }
  template <int MODE> DI void run(const f32x4 (&acc)[2][2][4][2], const pg8::Unit& u, int wr, int wc, int fr, int fq) const {
#pragma unroll
    for (int ai = 0; ai < 2; ++ai)
#pragma unroll
      for (int m = 0; m < 4; ++m) {
        const int row = u.pm * 256 + ai * 128 + wr * 64 + m * 16 + fr;
#pragma unroll
        for (int bj = 0; bj < 2; ++bj) { store8<MODE>(row, u.pn * 256 + bj * 128 + wc * 32 + 8 * fq, acc[ai][bj][m][0], acc[ai][bj][m][1], u.part);
          if (MODE == EM_QROPE || MODE == EM_QKV) asm volatile("" ::: "memory"); }
      }
  }
  DI void operator()(const f32x4 (&acc)[2][2][4][2], const pg8::Unit& u, int wr, int wc, int fr, int fq) const {
    { int t_ = threadIdx.x; asm volatile("" : "+v"(t_)); fr = t_ & 15; fq = (t_ >> 4) & 3; }
    switch (mode) {
      case EM_BF16: run<EM_BF16>(acc, u, wr, wc, fr, fq); break;
      case EM_RELU2: run<EM_RELU2>(acc, u, wr, wc, fr, fq); break;
      case EM_F32: run<EM_F32>(acc, u, wr, wc, fr, fq); break;
      case EM_QKV: run<EM_QKV>(acc, u, wr, wc, fr, fq); break;
      case EM_SPLIT: run<EM_SPLIT>(acc, u, wr, wc, fr, fq); break;
      case EM_TAIL: run<EM_TAIL>(acc, u, wr, wc, fr, fq); break;
      default: run<EM_QROPE>(acc, u, wr, wc, fr, fq); break;
    }
  }
};
DI void run_gemm(LAS unsigned char* lds, const bf16* A, int lda, const bf16* Bt, int M, int N, int K, const EpiMode& E) {
  pg8::Gemm g{A, Bt, M, N, K, lda}; pg8::StaticOrder S; S.init(M, N, K, (int)gridDim.x, (int)blockIdx.x, E.mode == EM_TAIL ? 8 : E.mode == EM_SPLIT ? 2 : 1);
  pg8::gemm_phase<EpiMode, pg8::StaticOrder, true, true>(lds, g, S, E);
}
DI void row_x_prep(const float* xrow, bf16* xbrow, float* rstd_out, int lane) {
  const f32x4* xr = (const f32x4*)xrow + lane;
  f32x4 v[8]; float s = 0.f;
#pragma unroll
  for (int j = 0; j < 8; ++j) { v[j] = xr[64 * j]; s += (v[j].x * v[j].x + v[j].y * v[j].y) + (v[j].z * v[j].z + v[j].w * v[j].w); }
  const float rstd = rsqrtf(wave_sum(s) * (1.f / DM) + EPS);
  u32x2* x8 = (u32x2*)xbrow + lane;
#pragma unroll
  for (int j = 0; j < 8; ++j) { u32x2 w; w.x = cvtpk(v[j].x, v[j].y); w.y = cvtpk(v[j].z, v[j].w); x8[64 * j] = w; }
  if (lane == 0) *rstd_out = rstd;
}
template <bool XINB, bool XOUTB> DI void row_resid_norm(const bf16* trow, const bf16* trow2, int npart, const void* xin, void* xout, const float* gpost, float* rstd_out, int lane) {
  const u32x2* tr = (const u32x2*)trow + lane; const u32x2* tr2 = (const u32x2*)trow2 + lane; const f32x4* gr = (const f32x4*)gpost + lane;
  f32x4 t[8], x[8]; float s = 0.f;
#pragma unroll
  for (int j = 0; j < 8; ++j) {
    if (npart == 8) { f32x4 acc4 = {0.f, 0.f, 0.f, 0.f};
#pragma unroll
      for (int p = 0; p < 8; ++p) { const u32x2 w = (tr2 + (size_t)p * (1024 * 2048 / 4))[64 * j]; acc4 += (f32x4){bflo(w.x), bfhi(w.x), bflo(w.y), bfhi(w.y)}; }
      t[j] = acc4;
    } else { const u32x2 w = tr[64 * j]; u32x2 w2 = {0u, 0u}; if (npart == 1) w2 = tr2[64 * j]; t[j] = (f32x4){bflo(w.x) + bflo(w2.x), bfhi(w.x) + bfhi(w2.x), bflo(w.y) + bflo(w2.y), bfhi(w.y) + bfhi(w2.y)}; }
    s += (t[j].x * t[j].x + t[j].y * t[j].y) + (t[j].z * t[j].z + t[j].w * t[j].w); }
#pragma unroll
  for (int j = 0; j < 8; ++j) { if (XINB) { const u32x2 w = ((const u32x2*)xin + lane)[64 * j]; x[j] = (f32x4){bflo(w.x), bfhi(w.x), bflo(w.y), bfhi(w.y)}; } else x[j] = ((const f32x4*)xin + lane)[64 * j]; }
  const float rstd = rsqrtf(wave_sum(s) * (1.f / DM) + EPS);
  float s2 = 0.f;
#pragma unroll
  for (int j = 0; j < 8; ++j) { const f32x4 gg = gr[64 * j]; x[j] = x[j] + t[j] * rstd * gg; s2 += (x[j].x * x[j].x + x[j].y * x[j].y) + (x[j].z * x[j].z + x[j].w * x[j].w); }
  asm volatile("s_waitcnt vmcnt(0)" ::: "memory");
#pragma unroll
  for (int j = 0; j < 8; ++j) { if (XOUTB) { u32x2 w; w.x = cvtpk(x[j].x, x[j].y); w.y = cvtpk(x[j].z, x[j].w); ((u32x2*)xout + lane)[64 * j] = w; } else ((f32x4*)xout + lane)[64 * j] = x[j]; }
  if (rstd_out) { const float rstd2 = rsqrtf(wave_sum(s2) * (1.f / DM) + EPS); if (lane == 0) *rstd_out = rstd2; }
}
DI bf16* xb_row(float* outp, int m) { return (bf16*)((char*)outp + (size_t)m * 8192 + 4096); }
DI void row_mla(const bf16* d, int row, const float* qn, const float* kvn, unsigned char* ws, float* outp, int lane) {
  f32x4 a[2], c[2]; float sa = 0.f, sc = 0.f;
#pragma unroll
  for (int j = 0; j < 2; ++j) { const u32x2 wa = *(const u32x2*)(d + 4 * lane + 256 * j), wc = *(const u32x2*)(d + 512 + 4 * lane + 256 * j);
    a[j] = (f32x4){bflo(wa.x), bfhi(wa.x), bflo(wa.y), bfhi(wa.y)}; c[j] = (f32x4){bflo(wc.x), bfhi(wc.x), bflo(wc.y), bfhi(wc.y)};
    sa += (a[j].x * a[j].x + a[j].y * a[j].y) + (a[j].z * a[j].z + a[j].w * a[j].w); sc += (c[j].x * c[j].x + c[j].y * c[j].y) + (c[j].z * c[j].z + c[j].w * c[j].w); }
  const float ra = rsqrtf(wave_sum(sa) * (1.f / 512.f) + EPS), rc = rsqrtf(wave_sum(sc) * (1.f / 512.f) + EPS);
  bf16* cq = (bf16*)(ws + A_CQ) + (size_t)row * 512;
  bf16* ckv; bf16* kr; float* fckv; float* fkr;
  if (row < NPR) { ckv = (bf16*)(ws + A_CKVP) + (size_t)row * 512; kr = (bf16*)(ws + A_KRP) + (size_t)row * 64; fckv = outp + O_CKVP + (size_t)row * 512; fkr = outp + O_KRP + (size_t)row * 64; }
  else { const int rs = row - NPR, b = rs >> 6, i = rs & 63; const size_t r2 = (size_t)b * 2112 + 2048 + i;
    ckv = (bf16*)(ws + A_CKVS) + r2 * 512; kr = (bf16*)(ws + A_KRS) + r2 * 64; fckv = outp + O_CKVS + (size_t)rs * 512; fkr = outp + O_KRS + (size_t)rs * 64; }
#pragma unroll
  for (int j = 0; j < 2; ++j) {
    const f32x4 g1 = *(const f32x4*)(qn + 4 * lane + 256 * j), g2 = *(const f32x4*)(kvn + 4 * lane + 256 * j);
    const f32x4 q = a[j] * ra * g1, k = c[j] * rc * g2;
    u32x2 w; w.x = cvtpk(q.x, q.y); w.y = cvtpk(q.z, q.w); *(u32x2*)(cq + 4 * lane + 256 * j) = w;
    w.x = cvtpk(k.x, k.y); w.y = cvtpk(k.z, k.w); *(u32x2*)(ckv + 4 * lane + 256 * j) = w;
    *(f32x4*)(fckv + 4 * lane + 256 * j) = k;
  }
  if (lane < 32) {
    const float x1 = __uint_as_float((unsigned)d[1024 + lane] << 16), x2 = __uint_as_float((unsigned)d[1056 + lane] << 16);
    const float pos = (float)(row < NPR ? (row & 4095) : PAST + ((row - NPR) & 63));
    const float inv = exp2f(-(float)lane * 0.41524101186092029f);
    float sn, cs; sincos_cw(pos * inv, sn, cs);
    const float o1 = x1 * cs - x2 * sn, o2 = x2 * cs + x1 * sn;
    fkr[lane] = o1; fkr[32 + lane] = o2;
    *(unsigned*)(kr + 2 * lane) = cvtpk(o1, o2);
  }
}

DI unsigned f2bf(float f) { unsigned u = __builtin_bit_cast(unsigned, f); return (u + 0x7fffu + ((u >> 16) & 1u)) >> 16; }
DI unsigned pk2(float lo, float hi) { return f2bf(lo) | (f2bf(hi) << 16); }
template <int RMAP> DI void transpose_item(const float* W, int K, int N, bf16* WT, int row_off, LAS float* scr, int item, int lane, const float* gk = nullptr) {
  const int nblk = N / 64, kb = item / nblk, nb = item % nblk, k0 = 64 * kb, n0 = 64 * nb;
  const int lr = lane >> 4, lc = (lane & 15) * 4;
  f32x4 v[16];
#pragma unroll
  for (int i = 0; i < 16; ++i) v[i] = *(const f32x4*)(W + (size_t)(k0 + 4 * i + lr) * N + n0 + lc);
#pragma unroll
  for (int i = 0; i < 16; ++i) { LAS float* d = scr + (4 * i + lr) * 65 + lc; d[0] = v[i].x; d[1] = v[i].y; d[2] = v[i].z; d[3] = v[i].w; }
  asm volatile("s_waitcnt lgkmcnt(0)" ::: "memory");
  const int c = lane & 7;
  f32x4 ga = {1.f, 1.f, 1.f, 1.f}, gb = ga; if (gk) { ga = *(const f32x4*)(gk + k0 + 8 * c); gb = *(const f32x4*)(gk + k0 + 8 * c + 4); }
#pragma unroll
  for (int j = 0; j < 8; ++j) { const int n = (lane >> 3) + 8 * j; const LAS float* s = scr + (8 * c) * 65 + n;
    u32x4 o; o.x = cvtpk(s[0 * 65] * ga.x, s[1 * 65] * ga.y); o.y = cvtpk(s[2 * 65] * ga.z, s[3 * 65] * ga.w); o.z = cvtpk(s[4 * 65] * gb.x, s[5 * 65] * gb.y); o.w = cvtpk(s[6 * 65] * gb.z, s[7 * 65] * gb.w);
    int orow = row_off + n0 + n;
    if (RMAP == 1) { const int nn = n0 + n, h = nn / 192, e = nn % 192; if (e < 128) orow = h * 128 + e; else { const int jj = e - 128; orow = 2048 + h * 64 + (jj < 32 ? 2 * jj : 2 * (jj - 32) + 1); } }
    *(u32x4*)(WT + (size_t)orow * K + k0 + 8 * c) = o; }
  asm volatile("s_waitcnt lgkmcnt(0)" ::: "memory");
}
namespace att {
constexpr int SHM_V = 16384, SHM_K = 64 * 272, SHM_KR = 64 * 144;
constexpr int OFF_V = 0, OFF_K = 2 * SHM_V, OFF_KR = OFF_K + 2 * SHM_K, OFF_WS = OFF_KR + 2 * SHM_KR, OFF_BIAS = OFF_WS + 8 * 64 * 4, LDS_END = OFF_BIAS + 640 * 4;
#define KSWZ(row, colB) ((row) * 272 + (colB))
#define KRSWZ(row, colB) ((row) * 144 + (colB))
#define SBAR() __builtin_amdgcn_sched_barrier(0)
DI int crow(int r, int hi) { return (r & 3) + 8 * (r >> 2) + 4 * hi; }
struct Unit {
  const bf16* Q; const bf16* Qr; int ldq;
  const bf16* K; const bf16* V; const bf16* KR; int ldk;
  bf16* O; int ldo;
  int nt, nact, thi0, tlo0, qrel0;
  int fillb;
  const float* bias;
};
template <bool BAND> DI void partialSM(f32x16& p0, f32x16& p1, float& m_reg, float& mn, float& alpha, bool masked, const LAS float* tb, float C) {
  if (masked) {
#pragma unroll
    for (int r = 0; r < 16; ++r) { p0[r] = -1e30f; p1[r] = -1e30f; }
  } else if (BAND) {
#pragma unroll
    for (int r = 0; r < 16; ++r) { const int ko = (r & 3) + 8 * (r >> 2); p0[r] = fmaf(p0[r], C, tb[ko]); }
    SBAR();
#pragma unroll
    for (int r = 0; r < 16; ++r) { const int ko = (r & 3) + 8 * (r >> 2); p1[r] = fmaf(p1[r], C, tb[ko + 32]); }
  }
  const float CC = BAND ? 1.f : C;
  const float THRP = 11.5f / CC;
  float pmax = p0[0];
#pragma unroll
  for (int r = 1; r < 16; ++r) pmax = fmaxf(pmax, p0[r]);
#pragma unroll
  for (int r = 0; r < 16; ++r) pmax = fmaxf(pmax, p1[r]);
  { auto rr = __builtin_amdgcn_permlane32_swap(__float_as_uint(pmax), __float_as_uint(pmax), false, false);
    pmax = fmaxf(__uint_as_float(rr[0]), __uint_as_float(rr[1])); }
  if (__builtin_expect(__all(pmax - m_reg <= THRP), 1)) { mn = m_reg; alpha = 1.f; }
  else { mn = fmaxf(m_reg, pmax); alpha = __builtin_amdgcn_exp2f((m_reg - mn) * CC); m_reg = mn; }
  const float mnC = -mn * CC;
#pragma unroll
  for (int r = 0; r < 16; ++r) p0[r] = fmaf(p0[r], CC, mnC);
#pragma unroll
  for (int r = 0; r < 16; ++r) p1[r] = fmaf(p1[r], CC, mnC);
#pragma unroll
  for (int r = 0; r < 16; ++r) p0[r] = __builtin_amdgcn_exp2f(p0[r]);
}
DI void finishSM(f32x16& p0, f32x16& p1, float alpha, float& l_reg, bf16x8& pa0, bf16x8& pa1, bf16x8& pa2, bf16x8& pa3) {
#pragma unroll
  for (int r = 0; r < 16; ++r) p1[r] = __builtin_amdgcn_exp2f(p1[r]);
  float ps = 0;
#pragma unroll
  for (int r = 0; r < 16; ++r) ps += p0[r];
#pragma unroll
  for (int r = 0; r < 16; ++r) ps += p1[r];
  { auto rr = __builtin_amdgcn_permlane32_swap(__float_as_uint(ps), __float_as_uint(ps), false, false);
    ps = __uint_as_float(rr[0]) + __uint_as_float(rr[1]); }
  l_reg = l_reg * alpha + ps;
#define PK4(P, BASE, OUT) do { unsigned a0 = cvtpk(P[BASE + 0], P[BASE + 1]), a1 = cvtpk(P[BASE + 2], P[BASE + 3]);   \
    unsigned b0 = cvtpk(P[BASE + 4], P[BASE + 5]), b1 = cvtpk(P[BASE + 6], P[BASE + 7]);                              \
    auto r0 = __builtin_amdgcn_permlane32_swap(a0, b0, false, false); auto r1 = __builtin_amdgcn_permlane32_swap(a1, b1, false, false); \
    u32x4 w = {r0[0], r1[0], r0[1], r1[1]}; OUT = __builtin_bit_cast(bf16x8, w); } while (0)
  PK4(p0, 0, pa0); PK4(p0, 8, pa1); PK4(p1, 0, pa2); PK4(p1, 8, pa3);
#undef PK4
}
template <int NQ> DI void qkt(f32x16& p0, f32x16& p1, const LAS char* Ks, const LAS char* KRs, const bf16x8* qr, int r32, int hi) {
  p0 = f32x16{}; p1 = f32x16{};
#pragma unroll
  for (int d0 = 0; d0 < 8; ++d0) { const int cb = (d0 * 16 + hi * 8) * 2;
    const bf16x8 b0 = *(const LAS bf16x8*)(Ks + KSWZ(r32, cb));
    const bf16x8 b1 = *(const LAS bf16x8*)(Ks + KSWZ(32 + r32, cb));
    p0 = __builtin_amdgcn_mfma_f32_32x32x16_bf16(b0, qr[d0], p0, 0, 0, 0);
    p1 = __builtin_amdgcn_mfma_f32_32x32x16_bf16(b1, qr[d0], p1, 0, 0, 0); }
  if (NQ == 12) {
#pragma unroll
    for (int d0 = 0; d0 < 4; ++d0) { const int cb = (d0 * 16 + hi * 8) * 2;
      const bf16x8 b0 = *(const LAS bf16x8*)(KRs + KRSWZ(r32, cb));
      const bf16x8 b1 = *(const LAS bf16x8*)(KRs + KRSWZ(32 + r32, cb));
      p0 = __builtin_amdgcn_mfma_f32_32x32x16_bf16(b0, qr[8 + d0], p0, 0, 0, 0);
      p1 = __builtin_amdgcn_mfma_f32_32x32x16_bf16(b1, qr[8 + d0], p1, 0, 0, 0); }
  }
}
DI int v_st(int k, int c) { const int kk = (k & ~0xC) | ((k & 4) << 1) | ((k & 8) >> 1); return ((kk >> 3) * 4 + (c >> 5)) * 512 + ((kk & 7) * 32 + (c & 31)) * 2; }
DI int v_rd_base(int lane) { return ((lane & 3) << 3) | (((lane >> 2) & 3) << 6) | (((lane >> 4) & 1) << 5) | (((lane >> 5) & 1) << 8); }
constexpr int v_rd_off(int d0, int ks, int half) { return d0 * 512 + ks * 4096 + half * 2048; }
template <int OFF> DI s16x4 tr_read(int vb) { s16x4 r; asm volatile("ds_read_b64_tr_b16 %0, %1 offset:%2" : "=&v"(r) : "v"(vb), "i"(OFF) : "memory"); return r; }
template <int D0> DI void pv_one(f32x16& od, int vb, bf16x8 pa0, bf16x8 pa1, bf16x8 pa2, bf16x8 pa3) {
  const s16x4 l0 = tr_read<v_rd_off(D0, 0, 0)>(vb), h0 = tr_read<v_rd_off(D0, 0, 1)>(vb), l1 = tr_read<v_rd_off(D0, 1, 0)>(vb), h1 = tr_read<v_rd_off(D0, 1, 1)>(vb);
  const s16x4 l2 = tr_read<v_rd_off(D0, 2, 0)>(vb), h2 = tr_read<v_rd_off(D0, 2, 1)>(vb), l3 = tr_read<v_rd_off(D0, 3, 0)>(vb), h3 = tr_read<v_rd_off(D0, 3, 1)>(vb);
  asm volatile("s_waitcnt lgkmcnt(0)" ::: "memory"); SBAR();
#define PK(L, H) (bf16x8){L[0], L[1], L[2], L[3], H[0], H[1], H[2], H[3]}
  od = __builtin_amdgcn_mfma_f32_32x32x16_bf16(pa0, PK(l0, h0), od, 0, 0, 0);
  od = __builtin_amdgcn_mfma_f32_32x32x16_bf16(pa1, PK(l1, h1), od, 0, 0, 0);
  od = __builtin_amdgcn_mfma_f32_32x32x16_bf16(pa2, PK(l2, h2), od, 0, 0, 0);
  od = __builtin_amdgcn_mfma_f32_32x32x16_bf16(pa3, PK(l3, h3), od, 0, 0, 0);
#undef PK
}
DI void pv_d0(f32x16* o, int vb, bf16x8 pa0, bf16x8 pa1, bf16x8 pa2, bf16x8 pa3) {
  pv_one<0>(o[0], vb, pa0, pa1, pa2, pa3); pv_one<1>(o[1], vb, pa0, pa1, pa2, pa3); pv_one<2>(o[2], vb, pa0, pa1, pa2, pa3); pv_one<3>(o[3], vb, pa0, pa1, pa2, pa3);
}

template <bool BAND, int SD, bool ACT> DI void attn_unit_(const Unit& U, LAS char* lds, float C) {
  constexpr int NQ = BAND ? 8 : 12;
  int tid = threadIdx.x; asm volatile("" : "+v"(tid)); const int wid = __builtin_amdgcn_readfirstlane(tid >> 6), lane = tid & 63, r32 = lane & 31, hi = lane >> 5;
  LAS char* V_lds = lds + OFF_V; LAS char* K_lds = lds + OFF_K; LAS char* KR_lds = lds + OFF_KR;
  LAS float* wsf = (LAS float*)(lds + OFF_WS) + wid * 64; LAS float* li_l = wsf; LAS float* al_l = wsf + 32;
  LAS float* T3 = (LAS float*)(lds + OFF_BIAS);
  const int wq = wid & (U.nact - 1);
  const int cw = wid >> 1; const int t_hi = U.thi0 + cw; const int t_lo = (U.tlo0 + cw) > 0 ? (U.tlo0 + cw) : 0;
  float m_reg = -1e30f, l_reg = 0; f32x16 o[4] = {}; bf16x8 qr[NQ];
  if (ACT) {
    const bf16* Qw = U.Q + (size_t)(wq * 32 + r32) * U.ldq + hi * 8;
#pragma unroll
    for (int d0 = 0; d0 < 8; ++d0) qr[d0] = *(const bf16x8*)(Qw + d0 * 16);
    if (!BAND) { const bf16* Qw2 = U.Qr + (size_t)(wq * 32 + r32) * U.ldq + hi * 8;
#pragma unroll
      for (int d0 = 0; d0 < 4; ++d0) qr[(NQ == 12 ? 8 : 0) + d0] = *(const bf16x8*)(Qw2 + d0 * 16); }
  }
  if (BAND && U.fillb) { for (int j = tid; j < 640; j += 512) { int rel = 575 - j; rel = rel > 256 ? 256 : rel; T3[j] = U.bias[rel + 256] * LOG2E; } }
  const int sr = tid >> 4, sc = (tid & 15) * 8, vst0 = v_st(sr, sc), vst1 = v_st(32 + sr, sc);
  const int krr = tid >> 3, krc = (tid & 7) * 8;
  const int vb0 = (int)(uintptr_t)V_lds + v_rd_base(lane);
  const int jb0 = 575 - U.qrel0 - 32 * wq - r32 + 4 * hi;
  struct { bf16x8 vs0, vs1, ks0, ks1, kr; } sr_[SD];
  const int ntr = U.nt, NT = (U.nt + 1) & ~1;
  const unsigned vo0 = (unsigned)(sr * U.ldk + sc) * 2u, vo1 = (unsigned)((32 + sr) * U.ldk + sc) * 2u, vokr = (unsigned)(krr * 64 + krc) * 2u;
  const size_t tstep = (size_t)64 * U.ldk * 2;
#define SLOAD(i, t) do { const int tt_ = (t) < ntr ? (t) : ntr - 1; const char* kt_ = (const char*)U.K + tt_ * tstep; const char* vt_ = (const char*)U.V + tt_ * tstep;  \
    sr_[i].vs0 = *(const bf16x8*)(vt_ + vo0); sr_[i].vs1 = *(const bf16x8*)(vt_ + vo1);         \
    sr_[i].ks0 = *(const bf16x8*)(kt_ + vo0); sr_[i].ks1 = *(const bf16x8*)(kt_ + vo1);         \
    if (!BAND) sr_[i].kr = *(const bf16x8*)((const char*)U.KR + (size_t)tt_ * 8192 + vokr); } while (0)
#define SWRITE(b, i) do { *(LAS bf16x8*)(V_lds + (b) * SHM_V + vst0) = sr_[i].vs0; *(LAS bf16x8*)(V_lds + (b) * SHM_V + vst1) = sr_[i].vs1; \
    const int kc_ = sc * 2; *(LAS bf16x8*)(K_lds + (b) * SHM_K + KSWZ(sr, kc_)) = sr_[i].ks0; *(LAS bf16x8*)(K_lds + (b) * SHM_K + KSWZ(32 + sr, kc_)) = sr_[i].ks1; \
    if (!BAND) *(LAS bf16x8*)(KR_lds + (b) * SHM_KR + KRSWZ(krr, krc * 2)) = sr_[i].kr; } while (0)
#define SWAIT() do { if (SD == 2) asm volatile("s_waitcnt vmcnt(%0)" ::"n"(BAND ? 4 : 5) : "memory"); else asm volatile("s_waitcnt vmcnt(0)" ::: "memory"); } while (0)
#define RESC(a) do { if (__any((a) < 1.f)) { if (hi == 0) al_l[r32] = (a); asm volatile("s_waitcnt lgkmcnt(0)" ::: "memory"); \
    _Pragma("unroll") for (int d = 0; d < 4; ++d) _Pragma("unroll") for (int r = 0; r < 16; ++r) o[d][r] *= al_l[crow(r, hi)]; } } while (0)
#define MASKED(t) ((t) < t_lo || (t) > t_hi)
  f32x16 pA0, pA1, pB0, pB1; float mnA, mnB, alA = 1.f, alB = 1.f; bf16x8 pa0, pa1, pa2, pa3;
  { u32x4 zz = {0u, 0u, 0u, 0u}; asm volatile("" : "+v"(zz)); pa0 = pa1 = pa2 = pa3 = __builtin_bit_cast(bf16x8, zz); }
  constexpr int SE = 0, SO = SD - 1;
  if (ACT && wid >= 4) __builtin_amdgcn_s_setprio(1);
  SLOAD(SE, 0); if (SD == 2) SLOAD(SO, 1);
  if (SD == 2) asm volatile("s_waitcnt vmcnt(%0)" ::"n"(BAND ? 4 : 5) : "memory"); else asm volatile("s_waitcnt vmcnt(0)" ::: "memory");
  SWRITE(0, SE);
  if (SD == 2) { if (2 < NT) SLOAD(SE, 2); } else SLOAD(SO, 1);
  __syncthreads();
  if (ACT) { qkt<NQ>(pA0, pA1, K_lds, KR_lds, qr, r32, hi); partialSM<BAND>(pA0, pA1, m_reg, mnA, alA, MASKED(0), T3 + jb0, C); }
  SWAIT(); SWRITE(1, SO); __syncthreads();
  for (int j = 1; j + 1 < NT; j += 2) {
    SBAR();
    if (ACT) { qkt<NQ>(pB0, pB1, K_lds + SHM_K, KR_lds + SHM_KR, qr, r32, hi); finishSM(pA0, pA1, alA, l_reg, pa0, pa1, pa2, pa3); }
    SBAR();
    SLOAD(SO, j + SD); SBAR();
    if (ACT) { pv_d0(o, vb0, pa0, pa1, pa2, pa3); partialSM<BAND>(pB0, pB1, m_reg, mnB, alB, MASKED(j), T3 + jb0 + 64 * j, C); }
    __syncthreads(); SWAIT(); SWRITE(0, SE);
    if (ACT) RESC(alB);
    __syncthreads();
    SBAR();
    if (ACT) { qkt<NQ>(pA0, pA1, K_lds, KR_lds, qr, r32, hi); finishSM(pB0, pB1, alB, l_reg, pa0, pa1, pa2, pa3); }
    SBAR();
    if (SD == 1 || j + 3 < NT) SLOAD(SE, j + 1 + SD); SBAR();
    if (ACT) { pv_d0(o, vb0 + SHM_V, pa0, pa1, pa2, pa3); partialSM<BAND>(pA0, pA1, m_reg, mnA, alA, MASKED(j + 1), T3 + jb0 + 64 * (j + 1), C); }
    __syncthreads(); SWAIT(); SWRITE(1, SO);
    if (ACT) RESC(alA);
    __syncthreads();
  }
  SBAR();
  if (ACT) {
    qkt<NQ>(pB0, pB1, K_lds + SHM_K, KR_lds + SHM_KR, qr, r32, hi);
    finishSM(pA0, pA1, alA, l_reg, pa0, pa1, pa2, pa3); SBAR();
    pv_d0(o, vb0, pa0, pa1, pa2, pa3); partialSM<BAND>(pB0, pB1, m_reg, mnB, alB, MASKED(NT - 1), T3 + jb0 + 64 * (NT - 1), C);
  }
  __syncthreads();
  if (ACT) {
    RESC(alB);
    finishSM(pB0, pB1, alB, l_reg, pa0, pa1, pa2, pa3); SBAR();
    pv_d0(o, vb0 + SHM_V, pa0, pa1, pa2, pa3);
    if (hi == 0) li_l[r32] = l_reg; asm volatile("s_waitcnt lgkmcnt(0)" ::: "memory");
    float rli[16];
#pragma unroll
    for (int r = 0; r < 16; ++r) rli[r] = __builtin_amdgcn_rcpf(li_l[crow(r, hi)]);
    LAS char* stg = lds + (wid < 2 ? OFF_V + wid * 8192 : OFF_K + (wid - 2) * 8192);
#pragma unroll
    for (int r = 0; r < 16; ++r) { const int orow = crow(r, hi);
#pragma unroll
      for (int d0 = 0; d0 < 4; ++d0) *(LAS bf16*)(stg + orow * 256 + (d0 * 32 + r32) * 2) = (bf16)(cvtpk(o[d0][r] * rli[r], 0.f) & 0xffffu); }
    asm volatile("s_waitcnt lgkmcnt(0)" ::: "memory");
    bf16* Ow = U.O + (size_t)(wid * 32) * U.ldo;
#pragma unroll
    for (int i = 0; i < 8; ++i) { const int row = i * 4 + (lane >> 4), ch = lane & 15; const u32x4 v = *(const LAS u32x4*)(stg + row * 256 + ch * 16); *(u32x4*)(Ow + (size_t)row * U.ldo + ch * 8) = v; }
  }
  if (ACT && wid >= 4) __builtin_amdgcn_s_setprio(0);
  asm volatile("s_waitcnt vmcnt(0) lgkmcnt(0)" ::: "memory");
  __syncthreads();
#undef SLOAD
#undef SWRITE
#undef SWAIT
#undef RESC
#undef MASKED
}
template <bool BAND, int SD> DI void attn_unit(const Unit& U, LAS char* lds, float C) {
  const int wid = __builtin_amdgcn_readfirstlane((int)threadIdx.x >> 6);
  if (wid < U.nact) attn_unit_<BAND, SD, true>(U, lds, C); else attn_unit_<BAND, SD, false>(U, lds, C);
}
}
#define XB_TMO      128
#define XB_XCNT(j)  (256  + 64 * (j))
#define XB_XSUB(j)  (1280 + 64 * (j))
#define XB_XGEN(j)  (2304 + 64 * (j))
#define XB_TOP      3328
#define XB_TOPGEN   3392
#define XCD_BAR_WORDS 3456
#define XB_SPIN_CAP (1u << 18)

__device__ __forceinline__ unsigned xb_ld(unsigned* p)              { return __hip_atomic_load(p, __ATOMIC_RELAXED, __HIP_MEMORY_SCOPE_AGENT); }
__device__ __forceinline__ unsigned xb_add(unsigned* p, unsigned v) { return __hip_atomic_fetch_add(p, v, __ATOMIC_RELAXED, __HIP_MEMORY_SCOPE_AGENT); }
__device__ __forceinline__ unsigned xb_xcc_id() { return (unsigned)__builtin_amdgcn_s_getreg((3 << 11) | 20) & 0xFu; }
#define XB_SPIN(cond, bar) do { unsigned _sp = 0; while (cond) { __builtin_amdgcn_s_sleep(1); \
    if ((++_sp & 255u) == 0u) { if (xb_ld(&(bar)[XB_TMO])) break; if (_sp > XB_SPIN_CAP) { atomicAdd(&(bar)[XB_TMO], 1u); break; } } } } while (0)

struct XcdBarrier {
    unsigned* bar; unsigned x;
    volatile LAS unsigned* st;
};

__device__ __forceinline__ XcdBarrier xcd_barrier_post(unsigned* bar, volatile LAS unsigned* st) {
    XcdBarrier b; b.bar = bar; b.x = xb_xcc_id(); b.st = st;
    if (threadIdx.x == 0) (void)xb_add(&bar[XB_XCNT(b.x)], 1u);
    return b;
}
__device__ __forceinline__ void xcd_barrier_complete(unsigned* bar, unsigned x, unsigned& nloc, unsigned& nx) {
    const unsigned G = gridDim.x * gridDim.y * gridDim.z;
    unsigned sum, cnt, mine, sp = 0u;
    for (;;) {
        sum = 0u; cnt = 0u; mine = 0u;
#pragma unroll
        for (unsigned j = 0; j < 16; ++j) { const unsigned c = xb_ld(&bar[XB_XCNT(j)]); sum += c; cnt += (c > 0u) ? 1u : 0u; mine = (j == x) ? c : mine; }
        if (sum == G) break;
        __builtin_amdgcn_s_sleep(1);
        if ((++sp & 255u) == 0u) { if (xb_ld(&bar[XB_TMO])) break; if (sp > XB_SPIN_CAP) { atomicAdd(&bar[XB_TMO], 1u); break; } }
    }
    nloc = mine > 0u ? mine : 1u; nx = cnt > 0u ? cnt : 1u;
}

__device__ __forceinline__ void xcd_barrier(const XcdBarrier& b) {
    asm volatile("s_waitcnt vmcnt(0)" ::: "memory");
    __syncthreads();
    if (threadIdx.x == 0) {
        unsigned* bar = b.bar;
        __builtin_amdgcn_s_waitcnt(0);
        unsigned nloc = b.st[0], nx = b.st[1];
        if (nloc == 0u) { xcd_barrier_complete(bar, b.x, nloc, nx); b.st[0] = nloc; b.st[1] = nx; }
        const unsigned old = xb_add(&bar[XB_XSUB(b.x)], 1u);
        const unsigned gen = old / nloc;
        if (old + 1u == (gen + 1u) * nloc) {
            __builtin_amdgcn_fence(__ATOMIC_RELEASE, "agent");
            asm volatile("s_waitcnt vmcnt(0)" ::: "memory");
            const unsigned og = xb_add(&bar[XB_TOP], 1u);
            const unsigned tg = og / nx;
            if (og + 1u == (tg + 1u) * nx) xb_add(&bar[XB_TOPGEN], 1u);
            else XB_SPIN(xb_ld(&bar[XB_TOPGEN]) == tg, bar);
            __builtin_amdgcn_fence(__ATOMIC_ACQUIRE, "agent");
            xb_add(&bar[XB_XGEN(b.x)], 1u);
            asm volatile("s_waitcnt vmcnt(0)" ::: "memory");
        } else {
            XB_SPIN(xb_ld(&bar[XB_XGEN(b.x)]) == gen, bar);
            __builtin_amdgcn_fence(__ATOMIC_ACQUIRE, "agent");
            asm volatile("s_waitcnt vmcnt(0)" ::: "memory");
        }
    }
    __syncthreads();
}

#ifndef PROBE_PH
#define PROBE_PH 0
#endif
#ifndef PROBE_REP
#define PROBE_REP 0
#endif
#ifndef PROBE_SYNC
#define PROBE_SYNC 0
#endif
#ifndef BAND_SD
#define BAND_SD 2
#endif
#ifndef MLA_SD
#define MLA_SD 1
#endif
constexpr int NSTEPS = 20;
struct Args { const float* in[23]; float* out; unsigned char* ws; int ph_lo, ph_hi; };
constexpr int LDS_BYTES = 133120 + 1024;

typedef const __attribute__((address_space(4))) Args CArgs;
DI const float* xin_row(CArgs& a, int row) { return row < NPR ? a.in[0] + (size_t)row * DM : a.in[1] + (size_t)(row - NPR) * DM; }

DI bool get_gemm(int ph, bool tail8, CArgs& a, const bf16*& A, int& lda, const bf16*& Bt, int& M, int& N, int& K, EpiMode& E) {
  unsigned char* ws = a.ws;
  E.mode = EM_BF16; E.O = nullptr; E.O2 = nullptr; E.ldc = 0; E.F = nullptr; E.outp = a.out; E.ws = ws; E.rs = (const float*)(ws + A_RSTD); lda = 0;
  switch (ph) {
    case 1:  A = (const bf16*)((const char*)a.out + 4096); lda = 4096; Bt = (const bf16*)(ws + W_QKV); M = MT; N = 6144; K = 2048; E.mode = EM_QKV; return true;
    case 3:  A = (const bf16*)(ws + A_O0);   Bt = (const bf16*)(ws + W_AO);  M = MT; N = 2048; K = 2048; E.O = (bf16*)(ws + A_T); E.ldc = 2048; if (tail8) { E.mode = EM_TAIL; E.O2 = (bf16*)(ws + A_Q0); } return true;
    case 5:  A = (const bf16*)((const char*)a.out + 4096); lda = 4096; Bt = (const bf16*)(ws + W_F1);  M = MT; N = 8192; K = 2048; E.mode = EM_RELU2; E.O = (bf16*)(ws + A_HID); E.ldc = 8192; return true;
    case 6:  A = (const bf16*)(ws + A_HID);  Bt = (const bf16*)(ws + W_F2);  M = MT; N = 2048; K = 8192; E.mode = tail8 ? EM_TAIL : EM_SPLIT; E.O = (bf16*)(ws + A_T); E.O2 = (bf16*)(ws + (tail8 ? A_PF : A_H)); E.ldc = 2048; return true;
    case 8:  A = (const bf16*)((const char*)a.out + 4096); lda = 4096; Bt = (const bf16*)(ws + W_D);   M = MT; N = 1280; K = 2048; E.mode = EM_F32; E.F = (float*)(ws + A_DQ); E.ldc = 1280; return true;
    case 10: A = (const bf16*)(ws + A_CQ);   Bt = (const bf16*)(ws + W_UQ);  M = MT; N = 3072; K = 512; E.mode = EM_QROPE; E.O = (bf16*)(ws + A_QM); E.ldc = 3072; return true;
    case 11: A = (const bf16*)(ws + A_CKVP); Bt = (const bf16*)(ws + W_UKV); M = NPR; N = 4096; K = 512; E.O = (bf16*)(ws + A_KNV); E.ldc = 4096; return true;
    case 13: A = (const bf16*)(ws + A_CKVS); Bt = (const bf16*)(ws + W_UKV); M = 33792; N = 4096; K = 512; E.O = (bf16*)(ws + A_KNV); E.ldc = 4096; return true;
    case 15: A = (const bf16*)(ws + A_O1);   Bt = (const bf16*)(ws + W_MO);  M = MT; N = 2048; K = 2048; E.O = (bf16*)(ws + A_T); E.ldc = 2048; if (tail8) { E.mode = EM_TAIL; E.O2 = (bf16*)(ws + A_QM); } return true;
    case 17: A = (const bf16*)((const char*)a.out + 4096); lda = 4096; Bt = (const bf16*)(ws + W_F1);  M = MT; N = 8192; K = 2048; E.mode = EM_RELU2; E.O = (bf16*)(ws + A_HID); E.ldc = 8192; return true;
    case 18: A = (const bf16*)(ws + A_HID);  Bt = (const bf16*)(ws + W_F2);  M = MT; N = 2048; K = 8192; E.mode = tail8 ? EM_TAIL : EM_SPLIT; E.O = (bf16*)(ws + A_T); E.O2 = (bf16*)(ws + (tail8 ? A_PF : A_H)); E.ldc = 2048; return true;
    default: return false;
  }
}

__global__ void __launch_bounds__(512) fwd_mega(Args a_) {
  extern __shared__ __attribute__((aligned(16))) unsigned char lds_raw[];
  LAS unsigned char* lds = (LAS unsigned char*)lds_raw;
  cg::grid_group grid = cg::this_grid();
  if (threadIdx.x < 2) ((volatile LAS unsigned*)(lds + 133120))[threadIdx.x] = 0u;
  __syncthreads();
  const XcdBarrier xbar = xcd_barrier_post((unsigned*)(a_.ws + A_BAR), (volatile LAS unsigned*)(lds + 133120));
  for (int it_ = a_.ph_lo; it_ < a_.ph_hi; ++it_) {
    const int ph = it_ <= PROBE_PH ? it_ : (it_ <= PROBE_PH + PROBE_REP ? PROBE_PH : it_ - PROBE_REP);
    const __attribute__((address_space(4))) char* kp_ = (const __attribute__((address_space(4))) char*)__builtin_amdgcn_kernarg_segment_ptr();
    asm volatile("" : "+s"(kp_));
    CArgs& a = *(CArgs*)kp_;
    int tid = threadIdx.x; asm volatile("" : "+v"(tid));
    const int lane = tid & 63, wave = __builtin_amdgcn_readfirstlane(tid >> 6);
    const int G = gridDim.x, gw = blockIdx.x * 8 + wave, NGW = G * 8;
    const size_t gt = (size_t)blockIdx.x * 512 + tid, NGT = (size_t)G * 512;
    unsigned char* ws = a.ws; float* outp = a.out;
    const bf16* gA; const bf16* gB; int gM, gN, gK; EpiMode E;
    const bool tail8 = (G == 256);
    int gLda;
    if (get_gemm(ph, tail8, a, gA, gLda, gB, gM, gN, gK, E)) {
#ifndef NO_GEMM
      run_gemm(lds, gA, gLda ? gLda : gK, gB, gM, gN, gK, E);
#endif
      if (ph == 1 || ph == 5 || ph == 8 || ph == 17) {
        const int nwg_ = (gM / 256) * (gN / 256), rem_ = nwg_ % G;
        int li_ = (int)blockIdx.x, nl_ = G;
        if (rem_ != 0) { li_ = (int)blockIdx.x - rem_; nl_ = li_ >= 0 ? G - rem_ : 0; }
        if (nl_ > 0) {
          LAS float* scr = (LAS float*)(lds + wave * 16640);
          const int w0 = li_ * 8 + wave, nw = nl_ * 8;
          if (ph == 1) {
            constexpr int I1 = 32 * 32, I2 = 32 * 8, I3 = 32 * 9, I4 = 8 * 48, I5 = 8 * 32, I6 = 8 * 32, I7 = 32 * 32, I8 = 32 * 128;
            constexpr int NIT = I1 + I2 + I3 + I4 + I5 + I6 + I7 + I8;
            for (int it = w0; it < NIT; it += nw) {
              int r = it;
              if (r < I1) { transpose_item<0>(a.in[11], 2048, 2048, (bf16*)(ws + W_AO), 0, scr, r, lane); continue; } r -= I1;
              if (r < I2) { transpose_item<0>(a.in[13], 2048, 512, (bf16*)(ws + W_D), 0, scr, r, lane, a.in[6] + DM); continue; } r -= I2;
              if (r < I3) { transpose_item<0>(a.in[16], 2048, 576, (bf16*)(ws + W_D), 512, scr, r, lane, a.in[6] + DM); continue; } r -= I3;
              if (r < I4) { transpose_item<1>(a.in[15], 512, 3072, (bf16*)(ws + W_UQ), 0, scr, r, lane); continue; } r -= I4;
              if (r < I5) { transpose_item<0>(a.in[18], 512, 2048, (bf16*)(ws + W_UKV), 0, scr, r, lane); continue; } r -= I5;
              if (r < I6) { transpose_item<0>(a.in[19], 512, 2048, (bf16*)(ws + W_UKV), 2048, scr, r, lane); continue; } r -= I6;
              if (r < I7) { transpose_item<0>(a.in[20], 2048, 2048, (bf16*)(ws + W_MO), 0, scr, r, lane); continue; } r -= I7;
              transpose_item<0>(a.in[21], 2048, 8192, (bf16*)(ws + W_F1), 0, scr, r, lane, a.in[8]);
            }
          } else if (ph == 5) {
            for (int it = w0; it < 128 * 32; it += nw) transpose_item<0>(a.in[22], 8192, 2048, (bf16*)(ws + W_F2), 0, scr, it, lane);
          } else if (ph == 8) {
            for (int it = w0; it < 32 * 128; it += nw) transpose_item<0>(a.in[21] + (size_t)2048 * 8192, 2048, 8192, (bf16*)(ws + W_F1), 0, scr, it, lane, a.in[8] + DM);
          } else {
            for (int it = w0; it < 128 * 32; it += nw) transpose_item<0>(a.in[22] + (size_t)2048 * 8192, 8192, 2048, (bf16*)(ws + W_F2), 0, scr, it, lane);
          }
        }
      }
    } else if (ph == 0 || ph == 7) {
      LAS float* scr = (LAS float*)(lds + wave * 16640);
      if (ph == 0) {
        for (int it = gw; it < 32 * 96; it += NGW) transpose_item<0>(a.in[10], 2048, 6144, (bf16*)(ws + W_QKV), 0, scr, it, lane, a.in[6]);
        { u32x4* z = (u32x4*)((bf16*)(ws + W_D) + (size_t)1088 * 2048); const size_t n16 = (size_t)192 * 2048 * 2 / 16;
          u32x4 zv = {0u, 0u, 0u, 0u}; asm volatile("" : "+v"(zv));
          for (size_t i = gt; i < n16; i += NGT) z[i] = zv; }
        { const size_t ng = (size_t)16 * 512 * 256;
#define CVT_A_LD(i, va, vb) const int isv##va = (i) >= ng; const size_t g##va = isv##va ? (i) - ng : (i); const float* s##va = a.in[isv##va ? 3 : 2] + g##va * 8; const f32x4 va = *(const f32x4*)s##va, vb = *(const f32x4*)(s##va + 4)
#define CVT_A_ST(va, vb) *(u32x4*)((bf16*)(ws + (isv##va ? A_VS : A_KS)) + (g##va / (512 * 256)) * 576 * 2048 + (g##va % (512 * 256)) * 8) = pack8(va, vb)
          size_t i = gt;
          for (; i + 3 * NGT < 2 * ng; i += 4 * NGT) { CVT_A_LD(i, p0, p1); CVT_A_LD(i + NGT, q0, q1); CVT_A_LD(i + 2 * NGT, r0, r1); CVT_A_LD(i + 3 * NGT, t0, t1);
            CVT_A_ST(p0, p1); CVT_A_ST(q0, q1); CVT_A_ST(r0, r1); CVT_A_ST(t0, t1); }
          for (; i < 2 * ng; i += NGT) { CVT_A_LD(i, p0, p1); CVT_A_ST(p0, p1); }
#undef CVT_A_LD
#undef CVT_A_ST
        }
        for (int m = gw; m < MT; m += NGW) row_x_prep(xin_row(a, m), xb_row(outp, m), (float*)(ws + A_RSTD) + m, lane);
      } else {
        for (int m = gw; m < MT; m += NGW)
          row_resid_norm<true, true>((const bf16*)(ws + A_T) + (size_t)m * DM, tail8 ? (const bf16*)(ws + A_PF) + (size_t)(m - NPR) * DM : (const bf16*)(ws + A_H) + (size_t)m * DM, tail8 ? (m < NPR ? 0 : 8) : 1, xb_row(outp, m), xb_row(outp, m), a.in[9], (float*)(ws + A_RSTD) + m, lane);
      }
    } else if (ph == 4) {
      for (int m = gw; m < MT; m += NGW)
        row_resid_norm<true, true>((const bf16*)(ws + A_T) + (size_t)m * DM, (const bf16*)(ws + A_Q0) + (size_t)(m - NPR) * DM, (tail8 && m >= NPR) ? 8 : 0, xb_row(outp, m), xb_row(outp, m), a.in[7], (float*)(ws + A_RSTD) + m, lane);
    } else if (ph == 16) {
      for (int m = gw; m < MT; m += NGW)
        row_resid_norm<true, true>((const bf16*)(ws + A_T) + (size_t)m * DM, (const bf16*)(ws + A_QM) + (size_t)(m - NPR) * DM, (tail8 && m >= NPR) ? 8 : 0, xb_row(outp, m), xb_row(outp, m), a.in[7] + DM, (float*)(ws + A_RSTD) + m, lane);
    } else if (ph == 19) {
      for (int m = gw; m < MT; m += NGW)
        row_resid_norm<true, false>((const bf16*)(ws + A_T) + (size_t)m * DM, tail8 ? (const bf16*)(ws + A_PF) + (size_t)(m - NPR) * DM : (const bf16*)(ws + A_H) + (size_t)m * DM, tail8 ? (m < NPR ? 0 : 8) : 1, xb_row(outp, m), outp + (size_t)m * DM, a.in[9] + DM, nullptr, lane);
    } else if (ph == 9) {
      for (int m = gw; m < MT; m += NGW) row_mla((const bf16*)(ws + A_DQ) + (size_t)m * 1280, m, a.in[14], a.in[17], ws, outp, lane);
      { const size_t ng = (size_t)16 * 2048 * 64;
#define CVT_C_LD(i, va, vb) const size_t g##va = (i); const float* s##va = a.in[4] + g##va * 8; const f32x4 va = *(const f32x4*)s##va, vb = *(const f32x4*)(s##va + 4)
#define CVT_C_ST(va, vb) *(u32x4*)((bf16*)(ws + A_CKVS) + (g##va / (2048 * 64)) * 2112 * 512 + (g##va % (2048 * 64)) * 8) = pack8(va, vb)
        size_t i = gt;
        for (; i + 3 * NGT < ng; i += 4 * NGT) { CVT_C_LD(i, p0, p1); CVT_C_LD(i + NGT, q0, q1); CVT_C_LD(i + 2 * NGT, r0, r1); CVT_C_LD(i + 3 * NGT, t0, t1);
          CVT_C_ST(p0, p1); CVT_C_ST(q0, q1); CVT_C_ST(r0, r1); CVT_C_ST(t0, t1); }
        for (; i < ng; i += NGT) { CVT_C_LD(i, p0, p1); CVT_C_ST(p0, p1); }
#undef CVT_C_LD
#undef CVT_C_ST
      }
      { const size_t ng = (size_t)16 * 2048 * 8;
        for (size_t i = gt; i < ng; i += NGT) { const size_t rowi = i >> 3; const int q = (int)(i & 7); const size_t b = rowi / 2048, r = rowi % 2048;
          const float* src = a.in[5] + rowi * 64 + 4 * q; const f32x4 x1 = *(const f32x4*)src, x2 = *(const f32x4*)(src + 32);
          u32x4 w; w.x = cvtpk(x1.x, x2.x); w.y = cvtpk(x1.y, x2.y); w.z = cvtpk(x1.z, x2.z); w.w = cvtpk(x1.w, x2.w);
          *(u32x4*)((bf16*)(ws + A_KRS) + (b * 2112 + r) * 64 + 8 * q) = w; } }
    } else if (ph == 2) {
      const float C = 0.08838834764831845f * LOG2E;
      for (int u = blockIdx.x; u < 1280; u += G) {
        att::Unit U; U.Qr = nullptr; U.KR = nullptr; U.ldq = 2048; U.ldk = 2048; U.ldo = 2048;
        U.fillb = (u == (int)blockIdx.x) || (G % 16 != 0);
        if (u < 1024) { const int h = u & 15, qb = (u >> 4) & 15, b = u >> 8, c0 = qb * 4, kc0 = c0 > 8 ? c0 - 8 : 0;
          const size_t rq = (size_t)b * 4096 + qb * 256, rk = (size_t)b * 4096 + kc0 * 64;
          U.Q = (const bf16*)(ws + A_Q0) + rq * 2048 + h * 128; U.K = (const bf16*)(ws + A_KP) + rk * 2048 + h * 128; U.V = (const bf16*)(ws + A_VP) + rk * 2048 + h * 128;
          U.O = (bf16*)(ws + A_O0) + rq * 2048 + h * 128; U.nt = c0 + 4 - kc0; U.nact = 8; U.thi0 = c0 - kc0; U.tlo0 = c0 - 8 - kc0; U.qrel0 = (c0 - kc0) * 64; U.bias = a.in[12] + h * 513;
        } else { const int us = u - 1024, h = us & 15, b = us >> 4; const size_t rq = (size_t)NPR + b * 64;
          U.Q = (const bf16*)(ws + A_Q0) + rq * 2048 + h * 128; U.K = (const bf16*)(ws + A_KS) + (size_t)b * 576 * 2048 + h * 128; U.V = (const bf16*)(ws + A_VS) + (size_t)b * 576 * 2048 + h * 128;
          U.O = (bf16*)(ws + A_O0) + rq * 2048 + h * 128; U.nt = 9; U.nact = 2; U.thi0 = 8; U.tlo0 = 0; U.qrel0 = 512; U.bias = a.in[12] + h * 513; }
#ifndef NO_BAND
        att::attn_unit<true, BAND_SD>(U, (LAS char*)lds, C);
#endif
      }
    } else if (ph == 12 || ph == 14) {
      const float C = 0.07216878364870322f * LOG2E;
      const int nunits = ph == 12 ? 1024 : 256;
      for (int i = blockIdx.x; i < nunits; i += G) {
        att::Unit U; U.ldq = 3072; U.ldk = 4096; U.ldo = 2048; U.bias = nullptr; U.qrel0 = 0; U.tlo0 = -100000; U.fillb = 0;
        if (ph == 12) { const int rnd = i >> 8, v = i & 255, bh = v >> 2, s = v & 3, qb = rnd == 0 ? s : rnd == 1 ? 7 - s : rnd == 2 ? 8 + s : 15 - s, b = bh >> 4, h = bh & 15;
          const size_t rq = (size_t)b * 4096 + qb * 256, rk = (size_t)b * 4096;
          U.Q = (const bf16*)(ws + A_QM) + rq * 3072 + h * 128; U.Qr = (const bf16*)(ws + A_QM) + rq * 3072 + 2048 + h * 64;
          U.K = (const bf16*)(ws + A_KNV) + rk * 4096 + h * 128; U.V = (const bf16*)(ws + A_KNV) + rk * 4096 + 2048 + h * 128; U.KR = (const bf16*)(ws + A_KRP) + rk * 64;
          U.O = (bf16*)(ws + A_O1) + rq * 2048 + h * 128; U.nt = qb * 4 + 4; U.nact = 8; U.thi0 = qb * 4;
        } else { const int b = i >> 4, h = i & 15; const size_t rq = (size_t)NPR + b * 64, rk = (size_t)b * 2112;
          U.Q = (const bf16*)(ws + A_QM) + rq * 3072 + h * 128; U.Qr = (const bf16*)(ws + A_QM) + rq * 3072 + 2048 + h * 64;
          U.K = (const bf16*)(ws + A_KNV) + rk * 4096 + h * 128; U.V = (const bf16*)(ws + A_KNV) + rk * 4096 + 2048 + h * 128; U.KR = (const bf16*)(ws + A_KRS) + rk * 64;
          U.O = (bf16*)(ws + A_O1) + rq * 2048 + h * 128; U.nt = 33; U.nact = 2; U.thi0 = 32; }
#ifndef NO_MLA
        att::attn_unit<false, MLA_SD>(U, (LAS char*)lds, C);
#endif
      }
    }
    if (it_ + 1 < a_.ph_hi && ph != 10) { if (a_.ph_hi > 1000) grid.sync(); else xcd_barrier(xbar);
      for (int e_ = 0; e_ < PROBE_SYNC; ++e_) xcd_barrier(xbar); }
  }
}

#ifndef MULTI_LAUNCH
#define MULTI_LAUNCH 0
#endif
extern "C" void kernel_launch(void* const* d_in, const int* in_sizes, int n_in, void* d_out, int out_size, void* d_ws, size_t ws_size, hipStream_t stream) {
  static int grid = 0;
  if (grid == 0) {
    if (n_in != 23 || out_size != (int)O_END || ws_size < WS_NEED) { fprintf(stderr, "kernel_launch: unexpected shapes n_in %d out %d ws %zu (need %zu)\n", n_in, out_size, ws_size, (size_t)WS_NEED); grid = -1; return; }
    int dev = 0, cus = 0, per_cu = 0;
    hipGetDevice(&dev); hipDeviceGetAttribute(&cus, hipDeviceAttributeMultiprocessorCount, dev);
    if (hipFuncSetAttribute((const void*)fwd_mega, hipFuncAttributeMaxDynamicSharedMemorySize, LDS_BYTES) != hipSuccess) { fprintf(stderr, "hipFuncSetAttribute failed\n"); grid = -1; return; }
    hipOccupancyMaxActiveBlocksPerMultiprocessor(&per_cu, (const void*)fwd_mega, 512, LDS_BYTES);
    (void)hipGetLastError();
    if (per_cu < 1) per_cu = 1;
    grid = cus;
  }
  if (grid < 0) return;
  if (hipMemsetAsync((char*)d_ws + A_BAR, 0, 16384, stream) != hipSuccess) { fprintf(stderr, "memset failed\n"); return; }
  Args a{};
  for (int i = 0; i < 23; ++i) a.in[i] = (const float*)d_in[i];
  a.out = (float*)d_out; a.ws = (unsigned char*)d_ws;
#if MULTI_LAUNCH
  for (int ph = 0; ph < NSTEPS; ++ph) { a.ph_lo = ph; a.ph_hi = ph + 1; hipLaunchKernelGGL(fwd_mega, dim3(grid), dim3(512), LDS_BYTES, stream, a); }
#else
  a.ph_lo = 0; a.ph_hi = NSTEPS + PROBE_REP;
  void* args[] = {&a};
  hipError_t e = hipLaunchCooperativeKernel((const void*)fwd_mega, dim3(grid), dim3(512), args, LDS_BYTES, stream);
  if (e != hipSuccess) fprintf(stderr, "cooperative launch failed: %s (grid %d)\n", hipGetErrorString(e), grid);
#endif
}
```
